# Optimizing an MI355X kernel written in HIP

```python
import jax
import jax.numpy as jnp
from jax import lax
import numpy as np


D_MODEL = 1024
BATCH = 1
SEQ = 16384
DEPTH = 4

GRID_W = 64
CTX_LEN = 256
N_MIXERS = 3
MIX_CONV = 0
MIX_ATTN = 1
MIX_MLSTM = 2
NORM_EPS = 1e-6
FFN_HIDDEN = 2816
CONV_WIDTH = 3
ATTN_HEAD_DIM = 128
ATTN_Q_HEADS = D_MODEL // ATTN_HEAD_DIM
ATTN_KV_HEADS = 2
ATTN_GROUP = ATTN_Q_HEADS // ATTN_KV_HEADS
ATTN_Q_DIM = ATTN_Q_HEADS * ATTN_HEAD_DIM
ATTN_KV_DIM = ATTN_KV_HEADS * ATTN_HEAD_DIM
ATTN_QKV_DIM = ATTN_Q_DIM + 2 * ATTN_KV_DIM
Q_BLOCK = 128
ROPE_THETA = 10000.0
MLSTM_HEADS = 4
MLSTM_DV = D_MODEL // MLSTM_HEADS
MLSTM_DK = MLSTM_DV // 2
MLSTM_CHUNK = 64
MLSTM_KD = MLSTM_HEADS * MLSTM_DK
MLSTM_N_GATES = 4 * MLSTM_HEADS
MLSTM_KVG_DIM = MLSTM_KD + D_MODEL + MLSTM_N_GATES
MLSTM_IN_DIM = MLSTM_KVG_DIM + MLSTM_KD + D_MODEL

kernel_name = 'hybrid_conv_gqa_mlstm_dit'


def _ctx_read_at_or_after(i):
    return any((j % N_MIXERS) != MIX_CONV for j in range(i, DEPTH))


def _rms(t, g):
    t32 = t.astype(jnp.float32)
    y = t32 * lax.rsqrt(jnp.mean(t32 * t32, axis=-1, keepdims=True) + NORM_EPS)
    return y.astype(t.dtype) * g


def _modulate(t, g, shift, scale):
    return _rms(t, g) * (1 + scale) + shift


def _swiglu(h, w13, w2):
    gte, up = jnp.split(h @ w13, 2, axis=-1)
    return (jax.nn.silu(gte) * up) @ w2


def _dwconv3(t, k):
    rhs = k[:, None, :].astype(t.dtype)
    pad = CONV_WIDTH // 2
    return lax.conv_general_dilated(t, rhs, window_strides=(1,), padding=[(pad, pad)],
                                    dimension_numbers=('NWC', 'WIO', 'NWC'),
                                    feature_group_count=t.shape[-1])


def _short_conv_mixer(h, w_in, k, w_out):
    bgate, cgate, xv = jnp.split(h @ w_in, 3, axis=-1)
    return (bgate * _dwconv3(cgate * xv, k)) @ w_out


def _axial_rope_tables(n_tok, dtype):
    rows = n_tok // GRID_W
    row = jnp.repeat(jnp.arange(rows), GRID_W).astype(jnp.float32)
    col = jnp.tile(jnp.arange(GRID_W), rows).astype(jnp.float32)
    seg = ATTN_HEAD_DIM // 2
    inv = ROPE_THETA ** (-jnp.arange(seg // 2, dtype=jnp.float32) / (seg // 2))
    ang_r = row[:, None] * inv
    ang_c = col[:, None] * inv
    ang = jnp.concatenate([ang_r, ang_r, ang_c, ang_c], axis=-1)
    return jnp.cos(ang).astype(dtype), jnp.sin(ang).astype(dtype)


def _apply_rope(t, cos, sin):
    ts = t.reshape(t.shape[:-1] + (2, 2, ATTN_HEAD_DIM // 4))
    rot = jnp.stack([-ts[..., 1, :], ts[..., 0, :]], axis=-2).reshape(t.shape)
    return t * cos[:, None, :] + rot * sin[:, None, :]


def _attend(q, k, v):
    s = jnp.einsum('bqhgd,bkhd->bhgqk', q, k).astype(jnp.float32) * (ATTN_HEAD_DIM ** -0.5)
    p = jax.nn.softmax(s, axis=-1).astype(v.dtype)
    return jnp.einsum('bhgqk,bkhd->bqhgd', p, v)


def _gqa_mixer(h, hc, with_ctx_out, w_qkv, q_g, k_g, w_o, cos, sin):
    bsz, t = h.shape[:2]
    tc = hc.shape[1]
    w_q, w_kv = w_qkv[:, :ATTN_Q_DIM], w_qkv[:, ATTN_Q_DIM:]

    def proj_q(u):
        return _rms((u @ w_q).reshape(u.shape[0], u.shape[1], ATTN_Q_HEADS, ATTN_HEAD_DIM), q_g)

    def proj_kv(u):
        kv = u @ w_kv
        kk = _rms(kv[..., :ATTN_KV_DIM].reshape(u.shape[0], u.shape[1], ATTN_KV_HEADS, ATTN_HEAD_DIM), k_g)
        vv = kv[..., ATTN_KV_DIM:].reshape(u.shape[0], u.shape[1], ATTN_KV_HEADS, ATTN_HEAD_DIM)
        return kk, vv

    q = _apply_rope(proj_q(h), cos, sin)
    k, v = proj_kv(h)
    k = _apply_rope(k, cos, sin)
    kc, vc = proj_kv(hc)
    k_all = jnp.concatenate([kc, k], axis=1)
    v_all = jnp.concatenate([vc, v], axis=1)
    nblk = t // Q_BLOCK
    qb = q.reshape(bsz, nblk, Q_BLOCK, ATTN_KV_HEADS, ATTN_GROUP, ATTN_HEAD_DIM).swapaxes(0, 1)
    ob = lax.map(lambda qi: _attend(qi, k_all, v_all), qb)
    y = ob.swapaxes(0, 1).reshape(bsz, t, D_MODEL) @ w_o
    yc = None
    if with_ctx_out:
        qc = proj_q(hc).reshape(bsz, tc, ATTN_KV_HEADS, ATTN_GROUP, ATTN_HEAD_DIM)
        yc = _attend(qc, kc, vc).reshape(bsz, tc, D_MODEL) @ w_o
    return y, yc


def _mlstm_scan(q, k, v, ig, fg, state):
    with_out = q is not None
    bsz, t, nh = ig.shape
    L = MLSTM_CHUNK
    nc = t // L

    def chunks(a):
        return a.reshape((bsz, nc, L) + a.shape[2:]).swapaxes(0, 1)

    causal = jnp.tril(jnp.ones((L, L), dtype=bool))

    def step(carry, xs):
        C, n, m = carry
        if with_out:
            qc, kc, vc, ic, fc = xs
        else:
            kc, vc, ic, fc = xs
        A = jnp.cumsum(jax.nn.log_sigmoid(fc), axis=1)
        A_end = A[:, -1]
        w_end = A_end[:, None] - A + ic
        m_new = jnp.maximum(A_end + m, jnp.max(w_end, axis=1))
        e_end = jnp.exp(w_end - m_new[:, None])
        decay = jnp.exp(A_end + m - m_new)
        C_new = decay[..., None, None] * C + jnp.einsum('bsh,bshd,bshv->bhdv', e_end, kc, vc)
        n_new = decay[..., None] * n + jnp.einsum('bsh,bshd->bhd', e_end, kc)
        if not with_out:
            return (C_new, n_new, m_new), None
        Dm = A[:, :, None] - A[:, None] + ic[:, None]
        Dm = jnp.where(causal[None, :, :, None], Dm, -jnp.inf)
        inter = A + m[:, None]
        m_t = jnp.maximum(jnp.max(Dm, axis=2), inter)
        w = jnp.exp(Dm - m_t[:, :, None])
        s = jnp.einsum('bthd,bshd->btsh', qc, kc) * w
        sc = jnp.exp(inter - m_t)
        h_num = jnp.einsum('btsh,bshv->bthv', s, vc) + sc[..., None] * jnp.einsum('bthd,bhdv->bthv', qc, C)
        nq = jnp.sum(s, axis=2) + sc * jnp.einsum('bthd,bhd->bth', qc, n)
        hh = h_num / jnp.maximum(jnp.abs(nq), jnp.exp(-m_t))[..., None]
        return (C_new, n_new, m_new), hh

    xs = (chunks(k), chunks(v), chunks(ig), chunks(fg))
    if with_out:
        xs = (chunks(q),) + xs
    state, hs = lax.scan(step, state, xs)
    if with_out:
        hs = hs.swapaxes(0, 1).reshape(bsz, t, nh, MLSTM_DV)
    return state, hs


def _mlstm_split_kvg(p, b_gate):
    bsz, t = p.shape[:2]
    k = p[..., :MLSTM_KD].reshape(bsz, t, MLSTM_HEADS, MLSTM_DK).astype(jnp.float32) * (MLSTM_DK ** -0.5)
    v = p[..., MLSTM_KD:MLSTM_KD + D_MODEL].reshape(bsz, t, MLSTM_HEADS, MLSTM_DV).astype(jnp.float32)
    g = (p[..., MLSTM_KD + D_MODEL:MLSTM_KVG_DIM] + b_gate.reshape(-1)).astype(jnp.float32)
    return k, v, g.reshape(bsz, t, 4, MLSTM_HEADS)


def _mlstm_split_qo(p):
    bsz, t = p.shape[:2]
    q = p[..., MLSTM_KVG_DIM:MLSTM_KVG_DIM + MLSTM_KD].reshape(bsz, t, MLSTM_HEADS, MLSTM_DK).astype(jnp.float32)
    return q, p[..., MLSTM_KVG_DIM + MLSTM_KD:]


def _rev(a, d):
    return jnp.flip(a, axis=1) if d == 1 else a


def _mlstm_out(hh, o, norm_g, w_o):
    bsz, t = hh.shape[:2]
    hn = _rms(hh.astype(o.dtype), norm_g.reshape(MLSTM_HEADS, MLSTM_DV)).reshape(bsz, t, D_MODEL)
    return (jax.nn.sigmoid(o) * hn) @ w_o


def _mlstm_mixer(h, hc, with_ctx_out, w_in, b_gate, norm_g, w_o):
    bsz = h.shape[0]
    p = h @ w_in
    k, v, g = _mlstm_split_kvg(p, b_gate)
    q, o = _mlstm_split_qo(p)
    if with_ctx_out:
        pc = hc @ w_in
        qc, oc = _mlstm_split_qo(pc)
    else:
        pc = hc @ w_in[:, :MLSTM_KVG_DIM]
        qc, oc = None, None
    kc, vc, gc = _mlstm_split_kvg(pc, b_gate)
    zero = (jnp.zeros((bsz, MLSTM_HEADS, MLSTM_DK, MLSTM_DV), jnp.float32),
            jnp.zeros((bsz, MLSTM_HEADS, MLSTM_DK), jnp.float32),
            jnp.zeros((bsz, MLSTM_HEADS), jnp.float32))
    lat_out, ctx_out = [], []
    for d in range(2):
        ig, fg = 2 * d, 2 * d + 1
        st_ctx, y_ctx = _mlstm_scan(_rev(qc, d) if with_ctx_out else None, _rev(kc, d), _rev(vc, d),
                                    _rev(gc[:, :, ig], d), _rev(gc[:, :, fg], d), zero)
        _, y_lat = _mlstm_scan(_rev(q, d), _rev(k, d), _rev(v, d),
                               _rev(g[:, :, ig], d), _rev(g[:, :, fg], d), st_ctx)
        lat_out.append(_rev(y_lat, d))
        if with_ctx_out:
            ctx_out.append(_rev(y_ctx, d))
    y = _mlstm_out(lat_out[0] + lat_out[1], o, norm_g, w_o)
    yc = _mlstm_out(ctx_out[0] + ctx_out[1], oc, norm_g, w_o) if with_ctx_out else None
    return y, yc


def setup_inputs(seed: int = 0) -> dict:
    key = jax.random.key(seed)
    keys = list(jax.random.split(key, 32))
    f32 = jnp.float32

    def nk():
        return keys.pop()

    def w(shape, fan_in, scale=1.0):
        return jax.random.normal(nk(), shape, f32) * (scale * fan_in ** -0.5)

    n_conv = sum(1 for i in range(DEPTH) if i % N_MIXERS == MIX_CONV)
    n_attn = sum(1 for i in range(DEPTH) if i % N_MIXERS == MIX_ATTN)
    n_mlstm = sum(1 for i in range(DEPTH) if i % N_MIXERS == MIX_MLSTM)
    D = D_MODEL
    gate_bias = jnp.concatenate([
        -3.0 + 0.1 * jax.random.normal(nk(), (n_mlstm, 1, MLSTM_HEADS), f32),
        3.0 + 3.0 * jax.random.uniform(nk(), (n_mlstm, 1, MLSTM_HEADS), f32),
        -3.0 + 0.1 * jax.random.normal(nk(), (n_mlstm, 1, MLSTM_HEADS), f32),
        3.0 + 3.0 * jax.random.uniform(nk(), (n_mlstm, 1, MLSTM_HEADS), f32)], axis=1)
    return {
        'x': jax.random.normal(nk(), (BATCH, SEQ, D), f32),
        'c': jax.random.normal(nk(), (BATCH, D), f32),
        'ctx': jax.random.normal(nk(), (BATCH, CTX_LEN, D), f32),
        'c_ctx': jax.random.normal(nk(), (D,), f32),
        'mod_w': w((DEPTH, D, 9 * D), D, 0.5),
        'mod_b': 0.02 * jax.random.normal(nk(), (DEPTH, 9 * D), f32),
        'norm_g': 1.0 + 0.05 * jax.random.normal(nk(), (DEPTH, 3, D), f32),
        'ffn_w13': w((DEPTH, 2, D, 2 * FFN_HIDDEN), D),
        'ffn_w2': w((DEPTH, 2, FFN_HIDDEN, D), FFN_HIDDEN),
        'conv_w_in': w((n_conv, D, 3 * D), D),
        'conv_k': w((n_conv, CONV_WIDTH, D), CONV_WIDTH),
        'conv_w_out': w((n_conv, D, D), D),
        'attn_w_qkv': w((n_attn, D, ATTN_QKV_DIM), D),
        'attn_q_g': 1.0 + 0.05 * jax.random.normal(nk(), (n_attn, ATTN_HEAD_DIM), f32),
        'attn_k_g': 1.0 + 0.05 * jax.random.normal(nk(), (n_attn, ATTN_HEAD_DIM), f32),
        'attn_w_o': w((n_attn, D, D), D),
        'mlstm_w_in': w((n_mlstm, D, MLSTM_IN_DIM), D),
        'mlstm_b_gate': gate_bias,
        'mlstm_norm_g': 1.0 + 0.05 * jax.random.normal(nk(), (n_mlstm, D), f32),
        'mlstm_w_o': w((n_mlstm, D, D), D),
    }


def reference(x, c, ctx, c_ctx, mod_w, mod_b, norm_g, ffn_w13, ffn_w2,
              conv_w_in, conv_k, conv_w_out,
              attn_w_qkv, attn_q_g, attn_k_g, attn_w_o,
              mlstm_w_in, mlstm_b_gate, mlstm_norm_g, mlstm_w_o):
    bsz, n_tok, _ = x.shape
    cos, sin = _axial_rope_tables(n_tok, x.dtype)
    lat, cx = x, ctx
    counters = [0, 0, 0]
    for i in range(DEPTH):
        kind = i % N_MIXERS
        j = counters[kind]
        counters[kind] += 1
        ctx_out = _ctx_read_at_or_after(i + 1)
        if not _ctx_read_at_or_after(i):
            cx = None
        mod = (jax.nn.silu(c) @ mod_w[i] + mod_b[i]).reshape(bsz, 3, 3, 1, D_MODEL)
        modc = (jax.nn.silu(c_ctx) @ mod_w[i] + mod_b[i]).reshape(3, 3, D_MODEL)
        lat = lat + 0.5 * mod[:, 0, 2] * _swiglu(_modulate(lat, norm_g[i, 0], mod[:, 0, 0], mod[:, 0, 1]), ffn_w13[i, 0], ffn_w2[i, 0])
        if cx is not None:
            cx = cx + 0.5 * modc[0, 2] * _swiglu(_modulate(cx, norm_g[i, 0], modc[0, 0], modc[0, 1]), ffn_w13[i, 0], ffn_w2[i, 0])
        h = _modulate(lat, norm_g[i, 1], mod[:, 1, 0], mod[:, 1, 1])
        hc = _modulate(cx, norm_g[i, 1], modc[1, 0], modc[1, 1]) if cx is not None else None
        if kind == MIX_CONV:
            y = _short_conv_mixer(h, conv_w_in[j], conv_k[j], conv_w_out[j])
            yc = _short_conv_mixer(hc, conv_w_in[j], conv_k[j], conv_w_out[j]) if ctx_out else None
        elif kind == MIX_ATTN:
            y, yc = _gqa_mixer(h, hc, ctx_out, attn_w_qkv[j], attn_q_g[j], attn_k_g[j], attn_w_o[j], cos, sin)
        else:
            y, yc = _mlstm_mixer(h, hc, ctx_out, mlstm_w_in[j], mlstm_b_gate[j], mlstm_norm_g[j], mlstm_w_o[j])
        lat = lat + mod[:, 1, 2] * y
        if ctx_out:
            cx = cx + modc[1, 2] * yc
            cx = cx + 0.5 * modc[2, 2] * _swiglu(_modulate(cx, norm_g[i, 2], modc[2, 0], modc[2, 1]), ffn_w13[i, 1], ffn_w2[i, 1])
        else:
            cx = None
        lat = lat + 0.5 * mod[:, 2, 2] * _swiglu(_modulate(lat, norm_g[i, 2], mod[:, 2, 0], mod[:, 2, 1]), ffn_w13[i, 1], ffn_w2[i, 1])
    return lat
```

```cpp
#include <hip/hip_runtime.h>
#include <hip/hip_cooperative_groups.h>
#include <cstdio>
#include <cstdint>
namespace cg = cooperative_groups;

#define LAS __attribute__((address_space(3)))
typedef unsigned short bf16_t;
typedef short bf16x8 __attribute__((ext_vector_type(8)));
typedef short s16x4 __attribute__((ext_vector_type(4)));
typedef float f32x4 __attribute__((ext_vector_type(4)));
typedef float f32x16 __attribute__((ext_vector_type(16)));
typedef unsigned u32x4 __attribute__((ext_vector_type(4)));
typedef unsigned u32x2 __attribute__((ext_vector_type(2)));

constexpr int DM = 1024, T = 16384, TC = 256, MT = T + TC, FF = 2816;
constexpr float EPS = 1e-6f;
constexpr int NTHREADS = 512, NWAVES = 8;
constexpr int LDS_BYTES = 131072 + 8192;
#ifndef PROBE
#define PROBE 0
#endif

constexpr size_t SZ_W13T = (size_t)8 * 5632 * 1024 * 2, SZ_W2T = (size_t)8 * 1024 * 2816 * 2, SZ_CINT = (size_t)2 * 3072 * 1024 * 2, SZ_COUTT = (size_t)2 * 1024 * 1024 * 2;
constexpr size_t SZ_QKVT = (size_t)1536 * 1024 * 2, SZ_SQ = (size_t)1024 * 1024 * 2, SZ_MLINT = (size_t)3072 * 1024 * 2;
constexpr size_t OFF_W13T = 0, OFF_W2T = OFF_W13T + SZ_W13T, OFF_CINT = OFF_W2T + SZ_W2T, OFF_COUTT = OFF_CINT + SZ_CINT, OFF_QKVT = OFF_COUTT + SZ_COUTT,
                 OFF_AOT = OFF_QKVT + SZ_QKVT, OFF_MLINT = OFF_AOT + SZ_SQ, OFF_MLOT = OFF_MLINT + SZ_MLINT, OFF_X = OFF_MLOT + SZ_SQ,
                 OFF_H = OFF_X + (size_t)MT * 1024 * 4, OFF_U = OFF_H + (size_t)MT * 1024 * 2, OFF_BIG = OFF_U + (size_t)MT * 1024 * 2,
                 OFF_MODV = OFF_BIG + (size_t)MT * 3072 * 2, OFF_GATES = OFF_MODV + (size_t)4 * 2 * 9216 * 4, OFF_ST = OFF_GATES + (size_t)MT * 16 * 4,
                 OFF_STN = OFF_ST + (size_t)65 * 8 * 32768 * 4, OFF_DEC = OFF_STN + (size_t)65 * 8 * 128 * 4, OFF_HH = OFF_DEC + 4096,
                 OFF_BAR = OFF_HH + (size_t)T * 1024 * 4, OFF_CTB = OFF_BAR + 16384, OFF_PART = OFF_CTB + (size_t)65 * 8 * 32768 * 2, WS_END = OFF_PART + (size_t)11 * 256 * 1024 * 4;
static_assert(WS_END <= (size_t)603979776, "workspace");

enum { OP_PREP = 0, OP_MOD, OP_W13, OP_W2, OP_CONV_IN, OP_CONV_GATE, OP_CONV_OUT, OP_QKV, OP_ROPE, OP_ATT, OP_ATT_OUT, OP_ML_IN, OP_ML_STATE, OP_ML_SCAN, OP_ML_OUT, OP_ML_PROJ };
struct Params {
    const float *x, *c, *ctx, *cctx, *mod_w, *mod_b, *norm_g, *w13, *w2, *conv_in, *conv_k, *conv_out, *qkv, *q_g, *k_g, *attn_o, *ml_in, *ml_b, *ml_g, *ml_o;
    float* out; unsigned char* ws;
    int nprog, pad;
    int prog[64][4];
};

__device__ __forceinline__ unsigned f2bf(float f) { unsigned u = __float_as_uint(f); return (u + 0x7fffu + ((u >> 16) & 1u)) >> 16; }
__device__ __forceinline__ unsigned pk2(float lo, float hi) { return f2bf(lo) | (f2bf(hi) << 16); }
__device__ __forceinline__ float bf2f(bf16_t b) { return __uint_as_float(((unsigned)b) << 16); }
__device__ __forceinline__ float blo(unsigned w) { return __uint_as_float(w << 16); }
__device__ __forceinline__ float bhi(unsigned w) { return __uint_as_float(w & 0xffff0000u); }
__device__ __forceinline__ float wave_sum(float v) {
#pragma unroll
    for (int o = 1; o < 64; o <<= 1) v += __shfl_xor(v, o);
    return v;
}
__device__ __forceinline__ float siluf(float x) { return x * __builtin_amdgcn_rcpf(1.f + __expf(-x)); }
__device__ __forceinline__ float sigmf(float x) { return __builtin_amdgcn_rcpf(1.f + __expf(-x)); }
__device__ __forceinline__ float logsigf(float x) { return fminf(x, 0.f) - log1pf(__expf(-fabsf(x))); }
__device__ __forceinline__ unsigned cvt_pk_bf16(float lo, float hi) { unsigned r; asm volatile("v_cvt_pk_bf16_f32 %0, %1, %2" : "=v"(r) : "v"(lo), "v"(hi)); return r; }

namespace pg8 {
constexpr int BM = 256, BK = 64, HALF = 128, HTB = HALF * BK * 2, STAGE_BYTES = 8 * HTB, NXCD = 8, WGM = 8;
__device__ __forceinline__ int lds_byte(int r, int c) { const int st = (r >> 4) * 2 + (c >> 5), rr = r & 15, cc = c & 31, ob = rr * 64 + cc * 2; return st * 1024 + (ob ^ (((ob >> 9) & 1) << 5)); }
__device__ __forceinline__ void stage_rc(int b, int& R, int& C) { const int st = b / 1024, sb = b % 1024, swz = sb ^ (((sb >> 9) & 1) << 5); R = (st >> 1) * 16 + swz / 64; C = (st & 1) * 32 + (swz % 64) / 2; }
__device__ __forceinline__ int perm32(int rho) { const int n = rho >> 4, i = rho & 15; return 8 * (i >> 2) + 4 * n + (i & 3); }
struct Unit { int pm, pn; };
struct Gemm { const bf16_t* A; const bf16_t* Bt; int M, N, K, lda; };
struct StaticOrder {
    int nM, nN, nwg, G, c;
    __device__ void init(int M, int N, int G_, int c_) { nM = M / BM; nN = N / BM; nwg = nM * nN; G = G_; c = c_; }
    __device__ bool next(int i, Unit& u) const {
        const long L = (long)i * G + c; if (L >= nwg) return false;
        int wgid = (int)L; { const int q = nwg / NXCD, r = nwg % NXCD, xcd = wgid % NXCD, off = wgid / NXCD; wgid = (xcd < r ? xcd * (q + 1) : r * (q + 1) + (xcd - r) * q) + off; }
        const int nig = WGM * nN, gid = wgid / nig, fm = gid * WGM, gsz = (nM - fm) < WGM ? (nM - fm) : WGM;
        u.pm = fm + ((wgid % nig) % gsz); u.pn = (wgid % nig) / gsz; return true;
    }
    __device__ __forceinline__ size_t aoff(const Unit& u, size_t tstep) const { return (size_t)u.pm * tstep; }
    __device__ __forceinline__ size_t boff(const Unit& u, size_t tstep) const { return (size_t)u.pn * tstep; }
};
struct SplitOrder {
    int nsub, G, c;
    __device__ bool next(int i, Unit& u) const { const int L = i * G + c; if (L >= nsub) return false; u.pm = L >> 2; u.pn = L & 3; return true; }
    __device__ __forceinline__ size_t aoff(const Unit& u, size_t) const { return (size_t)u.pm * 512; }
    __device__ __forceinline__ size_t boff(const Unit& u, size_t tstep) const { return (size_t)u.pn * tstep + (size_t)u.pm * 512; }
};
struct EpiPart {
    static constexpr bool PERM = false;
    float* Pp;
    __device__ __forceinline__ void operator()(const f32x4 (&acc)[2][2][4][2], const Unit& u, int wr, int wc, int fr, int fq) const {
        const int row0 = wr * 64 + fr, col0 = u.pn * BM + wc * 32 + 4 * fq;
        float* base = Pp + (size_t)u.pm * 256 * 1024;
#pragma unroll
        for (int ai = 0; ai < 2; ++ai)
#pragma unroll
            for (int m = 0; m < 4; ++m) { float* rowp = base + (size_t)(row0 + ai * HALF + m * 16) * 1024 + col0;
#pragma unroll
                for (int bj = 0; bj < 2; ++bj)
#pragma unroll
                    for (int n = 0; n < 2; ++n) *(f32x4*)(rowp + bj * HALF + n * 16) = acc[ai][bj][m][n]; }
    }
};
struct EpiSwiglu {
    static constexpr bool PERM = true;
    bf16_t* O; int ldc;
    __device__ __forceinline__ void operator()(const f32x4 (&acc)[2][2][4][2], const Unit& u, int wr, int wc, int fr, int fq) const {
        const int row0 = u.pm * BM + wr * 64 + fr, col0 = u.pn * 128 + wc * 32 + 8 * fq;
#pragma unroll
        for (int ai = 0; ai < 2; ++ai)
#pragma unroll
            for (int m = 0; m < 4; ++m) { bf16_t* rowp = O + (size_t)(row0 + ai * HALF + m * 16) * ldc + col0;
                const f32x4 g0 = acc[ai][0][m][0], g1 = acc[ai][0][m][1], u0 = acc[ai][1][m][0], u1 = acc[ai][1][m][1];
                u32x4 w; w.x = cvt_pk_bf16(siluf(g0[0]) * u0[0], siluf(g0[1]) * u0[1]); w.y = cvt_pk_bf16(siluf(g0[2]) * u0[2], siluf(g0[3]) * u0[3]);
                w.z = cvt_pk_bf16(siluf(g1[0]) * u1[0], siluf(g1[1]) * u1[1]); w.w = cvt_pk_bf16(siluf(g1[2]) * u1[2], siluf(g1[3]) * u1[3]);
                __builtin_nontemporal_store(w, (u32x4*)rowp); }
    }
};
struct EpiResid {
    static constexpr bool PERM = false;
    const float* src; float* dst; const float* gate_lat; const float* gate_ctx; float gs;
    __device__ __forceinline__ void operator()(const f32x4 (&acc)[2][2][4][2], const Unit& u, int wr, int wc, int fr, int fq) const {
        const int row0 = u.pm * BM + wr * 64 + fr, col0 = u.pn * BM + wc * 32 + 4 * fq;
        const float* gt = (u.pm >= T / BM) ? gate_ctx : gate_lat;
        f32x4 gv[2][2];
#pragma unroll
        for (int bj = 0; bj < 2; ++bj)
#pragma unroll
            for (int n = 0; n < 2; ++n) gv[bj][n] = *(const f32x4*)(gt + col0 + bj * HALF + n * 16) * gs;
#pragma unroll
        for (int ai = 0; ai < 2; ++ai) {
            f32x4 xv[4][2][2];
#pragma unroll
            for (int m = 0; m < 4; ++m) { const size_t ro = (size_t)(row0 + ai * HALF + m * 16) * DM + col0;
#pragma unroll
                for (int bj = 0; bj < 2; ++bj)
#pragma unroll
                    for (int n = 0; n < 2; ++n) xv[m][bj][n] = *(const f32x4*)(src + ro + bj * HALF + n * 16); }
#pragma unroll
            for (int m = 0; m < 4; ++m) { const size_t ro = (size_t)(row0 + ai * HALF + m * 16) * DM + col0;
#pragma unroll
                for (int bj = 0; bj < 2; ++bj)
#pragma unroll
                    for (int n = 0; n < 2; ++n) *(f32x4*)(dst + ro + bj * HALF + n * 16) = xv[m][bj][n] + gv[bj][n] * acc[ai][bj][m][n]; }
        }
    }
};
struct EpiBf16 {
    static constexpr bool PERM = true;
    bf16_t* O; int ldc;
    __device__ __forceinline__ void operator()(const f32x4 (&acc)[2][2][4][2], const Unit& u, int wr, int wc, int fr, int fq) const {
        const int row0 = u.pm * BM + wr * 64 + fr, col0 = u.pn * BM + wc * 32 + 8 * fq;
#pragma unroll
        for (int ai = 0; ai < 2; ++ai)
#pragma unroll
            for (int m = 0; m < 4; ++m) { bf16_t* rowp = O + (size_t)(row0 + ai * HALF + m * 16) * ldc + col0;
#pragma unroll
                for (int bj = 0; bj < 2; ++bj) { const f32x4 v0 = acc[ai][bj][m][0], v1 = acc[ai][bj][m][1];
                    u32x4 w; w.x = cvt_pk_bf16(v0[0], v0[1]); w.y = cvt_pk_bf16(v0[2], v0[3]); w.z = cvt_pk_bf16(v1[0], v1[1]); w.w = cvt_pk_bf16(v1[2], v1[3]);
                    *(u32x4*)(rowp + bj * HALF) = w; } }
    }
};

template <class Epi, class Sched>
__device__ __forceinline__ void gemm_phase(LAS unsigned char* lds, const Gemm g, const Sched& S, const Epi& E, const int tid) {
    const int wid = __builtin_amdgcn_readfirstlane(tid >> 6), lane = tid & 63, wr = wid >> 2, wc = wid & 3, fr = lane & 15, fq = lane >> 4;
    const int K = g.lda, nt = g.K / BK;
    unsigned voffA[2], voffB[2];
#pragma unroll
    for (int i = 0; i < 2; ++i) { int R, C; stage_rc(tid * 16 + i * 8192, R, C); const int Rb = Epi::PERM ? ((R & ~31) + perm32(R & 31)) : R;
        voffA[i] = (unsigned)(R * K + C) * 2u; voffB[i] = (unsigned)(Rb * K + C) * 2u; }
    const size_t kstep = (size_t)(BK * 2);
    const size_t hstep = (size_t)HALF * K * 2;
    const size_t tstep = 2 * hstep;
    const unsigned ldsw = (unsigned)wid * 1024u;
    const int aoff = lds_byte(wr * 64 + fr, fq * 8), boff = lds_byte(wc * 32 + fr, fq * 8);
#define PG8_SA(b, h) (((b) * 2 + (h)) * HTB)
#define PG8_SB(b, h) ((4 + (b) * 2 + (h)) * HTB)
#define PG8_STAGE(bufoff, gbase, voff) do { _Pragma("unroll") for (int _i = 0; _i < 2; ++_i) \
        __builtin_amdgcn_global_load_lds((const unsigned*)((const char*)(gbase) + (voff)[_i]), (LAS unsigned*)(lds + (bufoff) + ldsw + _i * 8192), 16, 0, 0); } while (0)
#define PG8_LDA(dst, b, h) do { _Pragma("unroll") for (int m = 0; m < 4; ++m) _Pragma("unroll") for (int k = 0; k < 2; ++k) dst[m][k] = *(const LAS bf16x8*)(lds + PG8_SA(b, h) + aoff + m * 2048 + k * 1024); } while (0)
#define PG8_LDB(dst, b, h) do { _Pragma("unroll") for (int n = 0; n < 2; ++n) _Pragma("unroll") for (int k = 0; k < 2; ++k) dst[n][k] = *(const LAS bf16x8*)(lds + PG8_SB(b, h) + boff + n * 2048 + k * 1024); } while (0)
#define PG8_MMA(ai, bj, At, Bt) do { __builtin_amdgcn_s_setprio(1); _Pragma("unroll") for (int m = 0; m < 4; ++m) _Pragma("unroll") for (int n = 0; n < 2; ++n) _Pragma("unroll") for (int k = 0; k < 2; ++k) \
        acc[ai][bj][m][n] = __builtin_amdgcn_mfma_f32_16x16x32_bf16(Bt[n][k], At[m][k], acc[ai][bj][m][n], 0, 0, 0); __builtin_amdgcn_s_setprio(0); } while (0)
#define PG8_WAIT_V(n) asm volatile("s_waitcnt vmcnt(" #n ")" ::: "memory")
#define PG8_WAIT_L(n) asm volatile("s_waitcnt lgkmcnt(" #n ")" ::: "memory")
#define PG8_BAR __builtin_amdgcn_s_barrier()
#define PG8_SCHED __builtin_amdgcn_sched_barrier(0)
    Unit cur, nxt; int ui = 0;
    if (!S.next(0, cur)) return;
    f32x4 acc[2][2][4][2];
#pragma unroll
    for (int a = 0; a < 2; ++a)
#pragma unroll
        for (int b = 0; b < 2; ++b)
#pragma unroll
            for (int m = 0; m < 4; ++m)
#pragma unroll
                for (int n = 0; n < 2; ++n) acc[a][b][m][n] = (f32x4){0.f, 0.f, 0.f, 0.f};
    bf16x8 At[4][2], B0[2][2], B1[2][2];
    const char* cA = (const char*)g.A + S.aoff(cur, tstep); const char* cB = (const char*)g.Bt + S.boff(cur, tstep);
    PG8_STAGE(PG8_SB(0, 0), cB, voffB); PG8_STAGE(PG8_SA(0, 0), cA, voffA); PG8_STAGE(PG8_SB(0, 1), cB + hstep, voffB); PG8_STAGE(PG8_SA(0, 1), cA + hstep, voffA);
    if (wr == 1) PG8_BAR;
    PG8_WAIT_V(4); PG8_BAR;
    PG8_STAGE(PG8_SB(1, 0), cB + kstep, voffB); PG8_STAGE(PG8_SA(1, 0), cA + kstep, voffA); PG8_STAGE(PG8_SB(1, 1), cB + hstep + kstep, voffB);
    PG8_WAIT_V(6); PG8_BAR;
    for (;;) {
        const bool has_next = S.next(ui + 1, nxt);
        const char* nA = has_next ? (const char*)g.A + S.aoff(nxt, tstep) : cA; const char* nB = has_next ? (const char*)g.Bt + S.boff(nxt, tstep) : cB;
        for (int t = 0; t < nt; t += 2) {
            const bool last = (t == nt - 2);
            const char* a1 = cA + (size_t)(t + 1) * kstep;
            const char* a2 = last ? nA : cA + (size_t)(t + 2) * kstep; const char* b2 = last ? nB : cB + (size_t)(t + 2) * kstep;
            const char* a3 = a2 + kstep; const char* b3 = b2 + kstep;
            PG8_LDB(B0, 0, 0); PG8_SCHED; PG8_LDA(At, 0, 0); PG8_STAGE(PG8_SA(1, 1), a1 + hstep, voffA);
            PG8_WAIT_L(8); PG8_BAR; PG8_WAIT_L(0); PG8_MMA(0, 0, At, B0); PG8_BAR; PG8_SCHED;
            PG8_LDB(B1, 0, 1); PG8_STAGE(PG8_SB(0, 0), b2, voffB);
            PG8_BAR; PG8_WAIT_L(0); PG8_MMA(0, 1, At, B1); PG8_BAR;
            PG8_LDA(At, 0, 1); PG8_STAGE(PG8_SA(0, 0), a2, voffA);
            PG8_BAR; PG8_WAIT_L(0); PG8_MMA(1, 0, At, B0); PG8_BAR; PG8_SCHED;
            PG8_STAGE(PG8_SB(0, 1), b2 + hstep, voffB);
            PG8_WAIT_V(6); PG8_BAR; PG8_MMA(1, 1, At, B1); PG8_BAR;
            PG8_LDB(B0, 1, 0); PG8_SCHED; PG8_LDA(At, 1, 0); PG8_STAGE(PG8_SA(0, 1), a2 + hstep, voffA);
            PG8_WAIT_L(8); PG8_BAR; PG8_WAIT_L(0); PG8_MMA(0, 0, At, B0); PG8_BAR; PG8_SCHED;
            PG8_LDB(B1, 1, 1); PG8_STAGE(PG8_SB(1, 0), b3, voffB);
            PG8_BAR; PG8_WAIT_L(0); PG8_MMA(0, 1, At, B1); PG8_BAR;
            PG8_LDA(At, 1, 1); PG8_STAGE(PG8_SA(1, 0), a3, voffA);
            PG8_BAR; PG8_WAIT_L(0); PG8_MMA(1, 0, At, B0); PG8_BAR; PG8_SCHED;
            PG8_STAGE(PG8_SB(1, 1), b3 + hstep, voffB);
            PG8_WAIT_V(6); PG8_BAR; PG8_MMA(1, 1, At, B1); PG8_BAR;
        }
        E(acc, cur, wr, wc, fr, fq);
        if (!has_next) break;
#pragma unroll
        for (int a = 0; a < 2; ++a)
#pragma unroll
            for (int b = 0; b < 2; ++b)
#pragma unroll
                for (int m = 0; m < 4; ++m)
#pragma unroll
                    for (int n = 0; n < 2; ++n) acc[a][b][m][n] = (f32x4){0.f, 0.f, 0.f, 0.f};
        cur = nxt; cA = nA; cB = nB; ++ui;
    }
    PG8_WAIT_V(0);
    if (wr == 0) PG8_BAR;
    PG8_BAR;
#undef PG8_SA
#undef PG8_SB
#undef PG8_STAGE
#undef PG8_LDA
#undef PG8_LDB
#undef PG8_MMA
#undef PG8_WAIT_V
#undef PG8_WAIT_L
#undef PG8_BAR
#undef PG8_SCHED
}
}

namespace att {
constexpr int D = 128, NW = 8, QBLK = 32, KVBLK = 64;
constexpr float SCALE = 0.088388347648318440f;
constexpr float THR = 8.f;
constexpr int LDQ = 1536, LDK = 1536, LDO = 1024;
constexpr size_t SHM_V = KVBLK * D * 2, SHM_K = KVBLK * D * 2;
#define KSWZ(row, colB) ((row) * 256 + ((colB) ^ (((row) & 7) << 4)))
#define SBAR() __builtin_amdgcn_sched_barrier(0)
__device__ __forceinline__ int crow(int r, int hi) { return (r & 3) + 8 * (r >> 2) + 4 * hi; }
__device__ __forceinline__ unsigned cvtpk(float lo, float hi) { unsigned r; asm volatile("v_cvt_pk_bf16_f32 %0, %1, %2" : "=v"(r) : "v"(lo), "v"(hi)); return r; }
__device__ __forceinline__ bf16x8 ld8(const bf16_t* p) { return *reinterpret_cast<const bf16x8*>(p); }
__device__ __forceinline__ void partialSM(f32x16& p0, f32x16& p1, float& m_reg, float& mn, float& alpha) {
    constexpr float C = SCALE * 1.4426950408889634f;
    float pmax = p0[0];
#pragma unroll
    for (int r = 1; r < 16; ++r) pmax = fmaxf(pmax, p0[r]);
#pragma unroll
    for (int r = 0; r < 16; ++r) pmax = fmaxf(pmax, p1[r]);
    { auto rr = __builtin_amdgcn_permlane32_swap(__float_as_uint(pmax), __float_as_uint(pmax), false, false);
      pmax = fmaxf(__uint_as_float(rr[0]), __uint_as_float(rr[1])); }
    if (__builtin_expect(__all(pmax - m_reg <= THR / SCALE), 1)) { mn = m_reg; alpha = 1.f; }
    else { mn = fmaxf(m_reg, pmax); alpha = __builtin_amdgcn_exp2f((m_reg - mn) * C); m_reg = mn; }
    float mnC = -mn * C;
#pragma unroll
    for (int r = 0; r < 16; ++r) p0[r] = fmaf(p0[r], C, mnC);
#pragma unroll
    for (int r = 0; r < 16; ++r) p1[r] = fmaf(p1[r], C, mnC);
#pragma unroll
    for (int r = 0; r < 16; ++r) p0[r] = __builtin_amdgcn_exp2f(p0[r]);
}
__device__ __forceinline__ void finishSM(f32x16& p0, f32x16& p1, float alpha, float& l_reg, bf16x8& pa0, bf16x8& pa1, bf16x8& pa2, bf16x8& pa3) {
#pragma unroll
    for (int r = 0; r < 16; ++r) p1[r] = __builtin_amdgcn_exp2f(p1[r]);
    float ps = 0;
#pragma unroll
    for (int r = 0; r < 16; ++r) ps += p0[r];
#pragma unroll
    for (int r = 0; r < 16; ++r) ps += p1[r];
    { auto rr = __builtin_amdgcn_permlane32_swap(__float_as_uint(ps), __float_as_uint(ps), false, false);
      ps = __uint_as_float(rr[0]) + __uint_as_float(rr[1]); }
    l_reg = l_reg * alpha + ps;
#define PK4(P, BASE, OUT) do { unsigned a0 = cvtpk(P[BASE + 0], P[BASE + 1]), a1 = cvtpk(P[BASE + 2], P[BASE + 3]);   \
    unsigned b0 = cvtpk(P[BASE + 4], P[BASE + 5]), b1 = cvtpk(P[BASE + 6], P[BASE + 7]);                              \
    auto r0 = __builtin_amdgcn_permlane32_swap(a0, b0, false, false); auto r1 = __builtin_amdgcn_permlane32_swap(a1, b1, false, false); \
    u32x4 w = {r0[0], r1[0], r0[1], r1[1]}; OUT = *reinterpret_cast<bf16x8*>(&w); } while (0)
    PK4(p0, 0, pa0); PK4(p0, 8, pa1); PK4(p1, 0, pa2); PK4(p1, 8, pa3);
#undef PK4
}
__device__ __forceinline__ void pk_p(const f32x16& p0, const f32x16& p1, bf16x8& pa0, bf16x8& pa1, bf16x8& pa2, bf16x8& pa3) {
#define PK4(P, BASE, OUT) do { unsigned a0 = cvtpk(P[BASE + 0], P[BASE + 1]), a1 = cvtpk(P[BASE + 2], P[BASE + 3]);   \
    unsigned b0 = cvtpk(P[BASE + 4], P[BASE + 5]), b1 = cvtpk(P[BASE + 6], P[BASE + 7]);                              \
    auto r0 = __builtin_amdgcn_permlane32_swap(a0, b0, false, false); auto r1 = __builtin_amdgcn_permlane32_swap(a1, b1, false, false); \
    u32x4 w = {r0[0], r1[0], r0[1], r1[1]}; OUT = *reinterpret_cast<bf16x8*>(&w); } while (0)
    PK4(p0, 0, pa0); PK4(p0, 8, pa1); PK4(p1, 0, pa2); PK4(p1, 8, pa3);
#undef PK4
}
__device__ __forceinline__ void qkt(f32x16& p0, f32x16& p1, const bf16_t* Ks, const bf16x8* qr, int r32, int hi) {
    p0 = f32x16{}; p1 = f32x16{};
#pragma unroll
    for (int d0 = 0; d0 < 8; ++d0) { int cb = (d0 * 16 + hi * 8) * 2;
        bf16x8 b0 = *reinterpret_cast<const bf16x8*>((const char*)Ks + KSWZ(r32, cb));
        bf16x8 b1 = *reinterpret_cast<const bf16x8*>((const char*)Ks + KSWZ(32 + r32, cb));
        p0 = __builtin_amdgcn_mfma_f32_32x32x16_bf16(b0, qr[d0], p0, 0, 0, 0);
        p1 = __builtin_amdgcn_mfma_f32_32x32x16_bf16(b1, qr[d0], p1, 0, 0, 0); }
}
__device__ __forceinline__ int v_st(int k, int c) { const int kk = (k & ~0xC) | ((k & 4) << 1) | ((k & 8) >> 1); return ((kk >> 3) * 4 + (c >> 5)) * 512 + ((kk & 7) * 32 + (c & 31)) * 2; }
__device__ __forceinline__ int v_rd_base(int lane) { return ((lane & 3) << 3) | (((lane >> 2) & 3) << 6) | (((lane >> 4) & 1) << 5) | (((lane >> 5) & 1) << 8); }
constexpr int v_rd_off(int d0, int ks, int half) { return d0 * 512 + ks * 4096 + half * 2048; }
template <int OFF> __device__ __forceinline__ s16x4 tr_read(int vb) {
    s16x4 r; asm volatile("ds_read_b64_tr_b16 %0, %1 offset:%2" : "=&v"(r) : "v"(vb), "i"(OFF) : "memory"); return r;
}
template <int D0> __device__ __forceinline__ void pv_one(f32x16& od, int vb, bf16x8 pa0, bf16x8 pa1, bf16x8 pa2, bf16x8 pa3) {
    const s16x4 l0 = tr_read<v_rd_off(D0, 0, 0)>(vb), h0 = tr_read<v_rd_off(D0, 0, 1)>(vb), l1 = tr_read<v_rd_off(D0, 1, 0)>(vb), h1 = tr_read<v_rd_off(D0, 1, 1)>(vb);
    const s16x4 l2 = tr_read<v_rd_off(D0, 2, 0)>(vb), h2 = tr_read<v_rd_off(D0, 2, 1)>(vb), l3 = tr_read<v_rd_off(D0, 3, 0)>(vb), h3 = tr_read<v_rd_off(D0, 3, 1)>(vb);
    asm volatile("s_waitcnt lgkmcnt(0)" ::: "memory"); SBAR();
#define PK(L, H) (bf16x8){L[0], L[1], L[2], L[3], H[0], H[1], H[2], H[3]}
    od = __builtin_amdgcn_mfma_f32_32x32x16_bf16(pa0, PK(l0, h0), od, 0, 0, 0);
    od = __builtin_amdgcn_mfma_f32_32x32x16_bf16(pa1, PK(l1, h1), od, 0, 0, 0);
    od = __builtin_amdgcn_mfma_f32_32x32x16_bf16(pa2, PK(l2, h2), od, 0, 0, 0);
    od = __builtin_amdgcn_mfma_f32_32x32x16_bf16(pa3, PK(l3, h3), od, 0, 0, 0);
#undef PK
}
__device__ __forceinline__ void pv_d0(f32x16* o, int vb, bf16x8 pa0, bf16x8 pa1, bf16x8 pa2, bf16x8 pa3) {
    pv_one<0>(o[0], vb, pa0, pa1, pa2, pa3); pv_one<1>(o[1], vb, pa0, pa1, pa2, pa3); pv_one<2>(o[2], vb, pa0, pa1, pa2, pa3); pv_one<3>(o[3], vb, pa0, pa1, pa2, pa3);
}
__device__ __forceinline__ void attn_dense_body(const bf16_t* __restrict__ Qb, const bf16_t* __restrict__ Kh,
                                                bf16_t* __restrict__ Ob, int seq, char* lds, const int tid) {
    const int wid = tid >> 6, lane = tid & 63, r32 = lane & 31, hi = lane >> 5;
    bf16_t* V_lds = (bf16_t*)lds; bf16_t* K_lds = (bf16_t*)(lds + 2 * SHM_V);
    float* ws = (float*)(lds + 2 * SHM_V + 2 * SHM_K) + wid * 64; float* li_l = ws; float* al_l = ws + 32;
    float m_reg = -1e30f, l_reg = 0; f32x16 o[4] = {}; bf16x8 qr[8];
    const bf16_t* Qw = Qb + (long)(wid * QBLK + r32) * LDQ + hi * 8;
#pragma unroll
    for (int d0 = 0; d0 < 8; ++d0) qr[d0] = ld8(Qw + d0 * 16);
    const int sr = tid >> 4, sc = (tid & 15) * 8, vst0 = v_st(sr, sc), vst1 = v_st(32 + sr, sc);
    const int vb0 = (int)(uintptr_t)V_lds + v_rd_base(lane);
    struct { bf16x8 vs0, vs1, ks0, ks1; } sr_[2];
    const unsigned so0 = (unsigned)(sr * LDK + sc) * 2u, so1 = (unsigned)((32 + sr) * LDK + sc) * 2u;
#define SLOAD(i, k0) do { const char* kb_ = (const char*)Kh + (size_t)(k0) * (LDK * 2); \
    sr_[i].vs0 = *(const bf16x8*)(kb_ + so0 + 512); sr_[i].vs1 = *(const bf16x8*)(kb_ + so1 + 512); \
    sr_[i].ks0 = *(const bf16x8*)(kb_ + so0); sr_[i].ks1 = *(const bf16x8*)(kb_ + so1); } while (0)
#define SWRITE(b, i) do { *(bf16x8*)((char*)V_lds + (b) * SHM_V + vst0) = sr_[i].vs0;          \
    *(bf16x8*)((char*)V_lds + (b) * SHM_V + vst1) = sr_[i].vs1; int kc = sc * 2;               \
    *(bf16x8*)((char*)K_lds + (b) * SHM_K + KSWZ(sr, kc)) = sr_[i].ks0;                       \
    *(bf16x8*)((char*)K_lds + (b) * SHM_K + KSWZ(32 + sr, kc)) = sr_[i].ks1; } while (0)
#define SWAIT() asm volatile("s_waitcnt vmcnt(4)" ::: "memory")
#define RESC(a) do { if (__any((a) < 1.f)) { if (hi == 0) al_l[r32] = (a); asm volatile("s_waitcnt lgkmcnt(0)" ::: "memory"); \
    _Pragma("unroll") for (int d = 0; d < 4; ++d) _Pragma("unroll") for (int r = 0; r < 16; ++r) o[d][r] *= al_l[crow(r, hi)]; } } while (0)
    f32x16 pA0, pA1, pB0, pB1; float mnA, mnB, alA, alB; bf16x8 pa0, pa1, pa2, pa3; const int NT = seq / KVBLK;
    constexpr int SE = 0, SO = 1;
    SLOAD(SE, 0); asm volatile("s_waitcnt vmcnt(0)" ::: "memory"); SWRITE(0, SE); __syncthreads();
    qkt(pA0, pA1, K_lds, qr, r32, hi); partialSM(pA0, pA1, m_reg, mnA, alA);
    SLOAD(SO, KVBLK); if (2 < NT) SLOAD(SE, 2 * KVBLK);
    SWAIT(); SWRITE(1, SO); __syncthreads();
    for (int j = 1; j + 1 < NT; j += 2) {
        SBAR(); qkt(pB0, pB1, (bf16_t*)((char*)K_lds + SHM_K), qr, r32, hi);
        finishSM(pA0, pA1, alA, l_reg, pa0, pa1, pa2, pa3); SBAR();
        SLOAD(SO, (j + 2) * KVBLK); SBAR();
        pv_d0(o, vb0, pa0, pa1, pa2, pa3); partialSM(pB0, pB1, m_reg, mnB, alB);
        __syncthreads(); SWAIT(); SWRITE(0, SE);
        RESC(alB); __syncthreads();
        SBAR(); qkt(pA0, pA1, K_lds, qr, r32, hi);
        finishSM(pB0, pB1, alB, l_reg, pa0, pa1, pa2, pa3); SBAR();
        if (j + 3 < NT) SLOAD(SE, (j + 3) * KVBLK); SBAR();
        pv_d0(o, vb0 + (int)SHM_V, pa0, pa1, pa2, pa3); partialSM(pA0, pA1, m_reg, mnA, alA);
        __syncthreads(); SWAIT(); SWRITE(1, SO);
        RESC(alA); __syncthreads();
    }
    SBAR(); qkt(pB0, pB1, (bf16_t*)((char*)K_lds + SHM_K), qr, r32, hi);
    finishSM(pA0, pA1, alA, l_reg, pa0, pa1, pa2, pa3); SBAR();
    pv_d0(o, vb0, pa0, pa1, pa2, pa3); partialSM(pB0, pB1, m_reg, mnB, alB);
    __syncthreads(); RESC(alB);
    finishSM(pB0, pB1, alB, l_reg, pa0, pa1, pa2, pa3); SBAR();
    pv_d0(o, vb0 + (int)SHM_V, pa0, pa1, pa2, pa3);
    if (hi == 0) li_l[r32] = l_reg; asm volatile("s_waitcnt lgkmcnt(0)" ::: "memory");
    float rli[16];
#pragma unroll
    for (int r = 0; r < 16; ++r) rli[r] = __builtin_amdgcn_rcpf(li_l[crow(r, hi)]);
    bf16_t* Ow = Ob + (long)(wid * QBLK) * LDO;
#pragma unroll
    for (int r = 0; r < 16; ++r) { int orow = crow(r, hi);
#pragma unroll
        for (int d0 = 0; d0 < 4; ++d0) Ow[(long)orow * LDO + d0 * 32 + r32] = (bf16_t)f2bf(o[d0][r] * rli[r]); }
#undef SLOAD
#undef SWRITE
#undef SWAIT
#undef RESC
}
}

#define XB_TMO      128
#define XB_XCNT(j)  (256  + 64 * (j))
#define XB_XSUB(j)  (1280 + 64 * (j))
#define XB_XGEN(j)  (2304 + 64 * (j))
#define XB_TOP      3328
#define XB_TOPGEN   3392
#define XCD_BAR_WORDS 3456
#define XB_SPIN_CAP (1u << 18)

__device__ __forceinline__ unsigned xb_ld(unsigned* p)              { return __hip_atomic_load(p, __ATOMIC_RELAXED, __HIP_MEMORY_SCOPE_AGENT); }
__device__ __forceinline__ unsigned xb_add(unsigned* p, unsigned v) { return __hip_atomic_fetch_add(p, v, __ATOMIC_RELAXED, __HIP_MEMORY_SCOPE_AGENT); }
__device__ __forceinline__ unsigned xb_xcc_id() { return (unsigned)__builtin_amdgcn_s_getreg((3 << 11) | 20) & 0xFu; }
#define XB_SPIN(cond, bar) do { unsigned _sp = 0; while (cond) { __builtin_amdgcn_s_sleep(1); \
    if ((++_sp & 255u) == 0u) { if (xb_ld(&(bar)[XB_TMO])) break; if (_sp > XB_SPIN_CAP) { atomicAdd(&(bar)[XB_TMO], 1u); break; } } } } while (0)

struct XcdBarrier {
    unsigned* bar; unsigned x;
    volatile LAS unsigned* st;
};

__device__ __forceinline__ XcdBarrier xcd_barrier_post(unsigned* bar, volatile LAS unsigned* st) {
    XcdBarrier b; b.bar = bar; b.x = xb_xcc_id(); b.st = st;
    if (threadIdx.x == 0) (void)xb_add(&bar[XB_XCNT(b.x)], 1u);
    return b;
}
__device__ __forceinline__ void xcd_barrier_complete(unsigned* bar, unsigned x, unsigned& nloc, unsigned& nx) {
    const unsigned G = gridDim.x * gridDim.y * gridDim.z;
    unsigned sum, cnt, mine, sp = 0u;
    for (;;) {
        sum = 0u; cnt = 0u; mine = 0u;
#pragma unroll
        for (unsigned j = 0; j < 16; ++j) { const unsigned c = xb_ld(&bar[XB_XCNT(j)]); sum += c; cnt += (c > 0u) ? 1u : 0u; mine = (j == x) ? c : mine; }
        if (sum == G) break;
        __builtin_amdgcn_s_sleep(1);
        if ((++sp & 255u) == 0u) { if (xb_ld(&bar[XB_TMO])) break; if (sp > XB_SPIN_CAP) { atomicAdd(&bar[XB_TMO], 1u); break; } }
    }
    nloc = mine > 0u ? mine : 1u; nx = cnt > 0u ? cnt : 1u;
}

__device__ __forceinline__ void xcd_barrier(const XcdBarrier& b, const bool leader) {
    asm volatile("s_waitcnt vmcnt(0)" ::: "memory");
    __syncthreads();
    if (leader) {
        unsigned* bar = b.bar;
        __builtin_amdgcn_s_waitcnt(0);
        unsigned nloc = b.st[0], nx = b.st[1];
        if (nloc == 0u) { xcd_barrier_complete(bar, b.x, nloc, nx); b.st[0] = nloc; b.st[1] = nx; }
        const unsigned old = xb_add(&bar[XB_XSUB(b.x)], 1u);
        const unsigned gen = old / nloc;
        if (old + 1u == (gen + 1u) * nloc) {
            __builtin_amdgcn_fence(__ATOMIC_RELEASE, "agent");
            asm volatile("s_waitcnt vmcnt(0)" ::: "memory");
            const unsigned og = xb_add(&bar[XB_TOP], 1u);
            const unsigned tg = og / nx;
            if (og + 1u == (tg + 1u) * nx) xb_add(&bar[XB_TOPGEN], 1u);
            else XB_SPIN(xb_ld(&bar[XB_TOPGEN]) == tg, bar);
            __builtin_amdgcn_fence(__ATOMIC_ACQUIRE, "agent");
            xb_add(&bar[XB_XGEN(b.x)], 1u);
            asm volatile("s_waitcnt vmcnt(0)" ::: "memory");
        } else {
            XB_SPIN(xb_ld(&bar[XB_XGEN(b.x)]) == gen, bar);
            __builtin_amdgcn_fence(__ATOMIC_ACQUIRE, "agent");
            asm volatile("s_waitcnt vmcnt(0)" ::: "memory");
        }
    }
    __syncthreads();
}


__device__ __forceinline__ int ml_tok(int dir, int c, int r) {
    if (c == 0) return dir ? (T + 255 - r) : (T + r);
    const int p = (c - 1) * 256 + r; return dir ? (T - 1 - p) : p;
}

__device__ __forceinline__ float block_scan256(float v, float* wtot, int tid, float& total) {
#pragma unroll
    for (int o = 1; o < 64; o <<= 1) { const float t = __shfl_up(v, o); if ((tid & 63) >= o) v += t; }
    if ((tid & 63) == 63 && tid < 256) wtot[tid >> 6] = v;
    __syncthreads();
    const float w0 = wtot[0], w1 = wtot[1], w2 = wtot[2], w3 = wtot[3];
    const int w = tid >> 6;
    v += (w > 0 ? w0 : 0.f) + (w > 1 ? w1 : 0.f) + (w > 2 ? w2 : 0.f);
    total = ((w0 + w1) + w2) + w3;
    return v;
}

__device__ __forceinline__ int srccol(int mode, int n) {
    if (mode == 1) { const int g = n >> 8, r = n & 255; return (r < 128) ? (g * 128 + r) : (FF + g * 128 + (r - 128)); }
    if (mode == 2) return n < 1536 ? n : n + 16;
    return n;
}
__device__ __forceinline__ void transpose_item(const float* W, int K, int Nsrc, int Ndst, int mode, bf16_t* WT, float* scr, int item, int lane) {
    const int nblk = Ndst / 32, kb = item / nblk, nb = item % nblk, k0 = 64 * kb, n0 = 32 * nb;
    const int sc_ = srccol(mode, n0 + (lane & 31));
    float tv[32];
    const float* Wp = W + (size_t)(k0 + (lane >> 5)) * Nsrc + sc_;
#pragma unroll
    for (int i = 0; i < 32; ++i) tv[i] = __builtin_nontemporal_load(Wp + (size_t)(2 * i) * Nsrc);
#pragma unroll
    for (int i = 0; i < 32; ++i) { const int kk = 2 * i + (lane >> 5); scr[kk * 33 + (lane & 31)] = tv[i]; }
    asm volatile("s_waitcnt lgkmcnt(0)" ::: "memory");
    const int c = lane & 7;
#pragma unroll
    for (int j = 0; j < 4; ++j) { const int n = (lane >> 3) + 8 * j; const float* s = scr + (8 * c) * 33 + n;
        u32x4 o; o.x = pk2(s[0 * 33], s[1 * 33]); o.y = pk2(s[2 * 33], s[3 * 33]); o.z = pk2(s[4 * 33], s[5 * 33]); o.w = pk2(s[6 * 33], s[7 * 33]);
        *(u32x4*)(WT + (size_t)(n0 + n) * K + k0 + 8 * c) = o; }
    asm volatile("s_waitcnt lgkmcnt(0)" ::: "memory");
}

__global__ void __launch_bounds__(NTHREADS, 2) fwd_megakernel(Params P) {
    extern __shared__ __attribute__((aligned(16))) unsigned char smem[];
    cg::grid_group grid = cg::this_grid();
    const int wave_s = __builtin_amdgcn_readfirstlane(threadIdx.x >> 6);
    if (threadIdx.x < 4) ((volatile LAS unsigned*)((LAS unsigned char*)smem + LDS_BYTES - 16))[threadIdx.x] = 0u;
    __syncthreads();
    const XcdBarrier xbar = xcd_barrier_post((unsigned*)(P.ws + OFF_BAR), (volatile LAS unsigned*)((LAS unsigned char*)smem + LDS_BYTES - 16));
    for (int ph = 0; ph < P.nprog; ++ph) {
        int wv_ = wave_s; asm volatile("" : "+s"(wv_));
        int tid; asm volatile("v_mbcnt_lo_u32_b32 %0, -1, 0\n\tv_mbcnt_hi_u32_b32 %0, -1, %0" : "=&v"(tid)); tid += wv_ * 64; asm volatile("" : "+v"(tid));
        int bid = blockIdx.x; asm volatile("" : "+s"(bid));
        __attribute__((address_space(1))) unsigned char* wsg_ = (__attribute__((address_space(1))) unsigned char*)P.ws; asm volatile("" : "+s"(wsg_));
        unsigned char* ws = (unsigned char*)wsg_;
        const int wave = wv_;
        const int G = gridDim.x;
#define lane (tid & 63)
#define gw (bid * NWAVES + wave)
#define NGW (G * NWAVES)
#define gtid (bid * NTHREADS + tid)
#define NTALL (G * NTHREADS)
#define W13T ((bf16_t*)(ws + OFF_W13T))
#define W2T ((bf16_t*)(ws + OFF_W2T))
#define CINT ((bf16_t*)(ws + OFF_CINT))
#define COUTT ((bf16_t*)(ws + OFF_COUTT))
#define QKVT ((bf16_t*)(ws + OFF_QKVT))
#define AOT ((bf16_t*)(ws + OFF_AOT))
#define MLINT ((bf16_t*)(ws + OFF_MLINT))
#define MLOT ((bf16_t*)(ws + OFF_MLOT))
#define X ((float*)(ws + OFF_X))
#define H ((bf16_t*)(ws + OFF_H))
#define U ((bf16_t*)(ws + OFF_U))
#define BIG ((bf16_t*)(ws + OFF_BIG))
#define MODV ((float*)(ws + OFF_MODV))
#define GATES ((float*)(ws + OFF_GATES))
#define ST ((float*)(ws + OFF_ST))
#define STN ((float*)(ws + OFF_STN))
#define DEC ((float*)(ws + OFF_DEC))
#define HH ((float*)(ws + OFF_HH))
        const int op = P.prog[ph][0], layer = P.prog[ph][1], a = P.prog[ph][2], M = P.prog[ph][3];
        int gtype = 0; const bf16_t* A = nullptr; const bf16_t* Bt = nullptr; int N = 0, K = 0, ldo = 0, sub = 0; float gs = 1.f; bf16_t* Obf = BIG; float* dst = X; const float* rsrc = X;
        switch (op) {
            case OP_W13:      gtype = 1; A = H;   Bt = W13T + (size_t)(layer * 2 + (a & 1)) * 5632 * 1024; N = 5632; K = 1024; ldo = (a & 8) ? -1 : FF; break;
            case OP_W2:       gtype = 2; A = BIG; Bt = W2T + (size_t)(layer * 2 + (a & 1)) * 1024 * 2816; N = 1024; K = 2816; sub = (a & 1) * 2; gs = 0.5f; if (a & 2) dst = P.out; if (a & 4) dst = HH; if (a & 16) rsrc = P.x; break;
            case OP_CONV_IN:  gtype = 3; A = H;   Bt = CINT + (size_t)a * 3072 * 1024; N = 3072; K = 1024; ldo = 3072; break;
            case OP_CONV_OUT: gtype = 2; A = U;   Bt = COUTT + (size_t)a * 1024 * 1024; N = 1024; K = 1024; sub = 1; break;
            case OP_QKV:      gtype = 3; A = H;   Bt = QKVT; N = 1536; K = 1024; ldo = 1536; break;
            case OP_ATT_OUT:  gtype = 2; A = U;   Bt = AOT; N = 1024; K = 1024; sub = 1; break;
            case OP_ML_IN:    gtype = 3; A = H;   Bt = MLINT; N = 3072; K = 1024; ldo = 3072; break;
            case OP_ML_PROJ:  gtype = 2; A = U;   Bt = MLOT; N = 1024; K = 1024; sub = 1; break;
            default: break;
        }
        if (gtype) {
            const bool split_ctx = (gtype == 2) && (M == MT);
            pg8::Gemm g{A, Bt, split_ctx ? T : M, N, K, K}; pg8::StaticOrder S; S.init(g.M, N, G, bid);
            if (gtype == 1) { pg8::EpiSwiglu E{Obf, ldo}; pg8::gemm_phase<pg8::EpiSwiglu, pg8::StaticOrder>((LAS unsigned char*)smem, g, S, E, tid); }
            else if (gtype == 2) {
                const float* gl = MODV + (size_t)(layer * 2 + 0) * 9216 + sub * 3072 + 2048; const float* gc = MODV + (size_t)(layer * 2 + 1) * 9216 + sub * 3072 + 2048;
                pg8::EpiResid E{rsrc, dst, gl, gc, gs}; pg8::gemm_phase<pg8::EpiResid, pg8::StaticOrder>((LAS unsigned char*)smem, g, S, E, tid);
                if (split_ctx) {
                    pg8::Gemm g2{A + (size_t)T * K, Bt, 256, N, 256, K}; pg8::SplitOrder S2{(K / 256) * 4, G, (bid + 128) % G};
                    pg8::EpiPart E2{(float*)(ws + OFF_PART)}; pg8::gemm_phase<pg8::EpiPart, pg8::SplitOrder>((LAS unsigned char*)smem, g2, S2, E2, tid);
                }
            }
            else { pg8::EpiBf16 E{Obf, ldo}; pg8::gemm_phase<pg8::EpiBf16, pg8::StaticOrder>((LAS unsigned char*)smem, g, S, E, tid); }
        }
        constexpr int I13 = 16 * 176, I2 = 44 * 32, ICI = 16 * 96, ISQ = 16 * 32, IQKV = 16 * 48;
#define PREP_MODV(l, blk0, nblk) do { float* red = (float*)smem; \
            for (int it = (blk0); it < 144; it += (nblk)) { \
                const int n0 = it * 64; \
                const float* Wp = P.mod_w + ((size_t)(l) * 1024 + wave * 128) * 9216 + n0 + lane; \
                float a0 = 0.f, a1 = 0.f; \
                for (int kb = 0; kb < 128; kb += 32) { float wv[32]; \
                    _Pragma("unroll") for (int k = 0; k < 32; ++k) wv[k] = __builtin_nontemporal_load(Wp + (size_t)(kb + k) * 9216); \
                    _Pragma("unroll") for (int k = 0; k < 32; ++k) { a0 += siluf(P.c[wave * 128 + kb + k]) * wv[k]; a1 += siluf(P.cctx[wave * 128 + kb + k]) * wv[k]; } } \
                red[(wave * 2 + 0) * 64 + lane] = a0; red[(wave * 2 + 1) * 64 + lane] = a1; \
                __syncthreads(); \
                if (tid < 128) { const int gq = tid >> 6, ln = tid & 63; float sm_ = 0.f; \
                    _Pragma("unroll") for (int w = 0; w < 8; ++w) sm_ += red[(w * 2 + gq) * 64 + ln]; \
                    MODV[(size_t)((l) * 2 + gq) * 9216 + n0 + ln] = sm_ + P.mod_b[(l) * 9216 + n0 + ln]; } \
                __syncthreads(); } } while (0)
#define PREP_NITEMS(l) (2 * I13 + 2 * I2 + (((l) % 3) == 1 ? IQKV : ICI) + ISQ)
#define PREP_TRANS(l, lo, hi, w0, nw) do { float* scr = (float*)(smem + wave * 8448); \
            for (int it = (lo) + (w0); it < (hi); it += (nw)) { int r = it; \
                if (r < 2 * I13) { const int mi = (l) * 2 + r / I13; transpose_item(P.w13 + (size_t)mi * 1024 * 5632, 1024, 5632, 5632, 1, W13T + (size_t)mi * 5632 * 1024, scr, r % I13, lane); continue; } r -= 2 * I13; \
                if (r < 2 * I2) { const int mi = (l) * 2 + r / I2; transpose_item(P.w2 + (size_t)mi * 2816 * 1024, 2816, 1024, 1024, 0, W2T + (size_t)mi * 1024 * 2816, scr, r % I2, lane); continue; } r -= 2 * I2; \
                const int kd = (l) % 3, jj = (l) / 3; \
                if (kd == 0) { if (r < ICI) { transpose_item(P.conv_in + (size_t)jj * 1024 * 3072, 1024, 3072, 3072, 0, CINT + (size_t)jj * 3072 * 1024, scr, r, lane); continue; } r -= ICI; \
                    transpose_item(P.conv_out + (size_t)jj * 1024 * 1024, 1024, 1024, 1024, 0, COUTT + (size_t)jj * 1024 * 1024, scr, r, lane); } \
                else if (kd == 1) { if (r < IQKV) { transpose_item(P.qkv, 1024, 1536, 1536, 0, QKVT, scr, r, lane); continue; } r -= IQKV; \
                    transpose_item(P.attn_o, 1024, 1024, 1024, 0, AOT, scr, r, lane); } \
                else { if (r < ICI) { transpose_item(P.ml_in, 1024, 3088, 3072, 2, MLINT, scr, r, lane); continue; } r -= ICI; \
                    transpose_item(P.ml_o, 1024, 1024, 1024, 0, MLOT, scr, r, lane); } } } while (0)
        if (op == OP_W13 && layer < 3) {
            const int nwg = (M / 256) * 22, nfull = nwg % G;
            if (nfull == 0 || bid >= nfull) {
                const int ib = nfull ? bid - nfull : bid, nidle = nfull ? G - nfull : G, l1 = layer + 1, tot = PREP_NITEMS(l1), cut = tot / 3;
                if ((a & 1) == 0) { PREP_MODV(l1, ib, nidle); PREP_TRANS(l1, 0, cut, ib * NWAVES + wave, nidle * NWAVES); }
                else { PREP_TRANS(l1, cut, tot, ib * NWAVES + wave, nidle * NWAVES); }
            }
        }
        if (op == OP_PREP) {
            PREP_MODV(0, bid, G);
            PREP_TRANS(0, 0, PREP_NITEMS(0), gw, NGW);
        } else if (op == OP_MOD) {
            const int subl = a & 15, nks = (a >> 4) & 255, psub = (a >> 12) & 15, player = (a >> 16) & 255; const float pgs = ((a >> 24) & 1) ? 0.5f : 1.f;
            for (int m = gw; m < M; m += NGW) {
                f32x4* xr = (f32x4*)(X + (size_t)m * 1024) + lane;
                f32x4 v[4]; float ss = 0.f;
                const float* xin = (a & (1 << 28)) ? (m < T ? P.x + (size_t)m * 1024 : P.ctx + (size_t)(m - T) * 1024) : (((a & (1 << 29)) && m >= T) ? P.ctx + (size_t)(m - T) * 1024 : X + (size_t)m * 1024);
#pragma unroll
                for (int j = 0; j < 4; ++j) v[j] = ((const f32x4*)xin + lane)[64 * j];
                if (m >= T && nks) {
                    const float* pg = MODV + (size_t)(player * 2 + 1) * 9216 + psub * 3072 + 2048;
                    const f32x4* pp = (const f32x4*)((const float*)(ws + OFF_PART) + (size_t)(m - T) * 1024) + lane;
#pragma unroll
                    for (int j = 0; j < 4; ++j) { f32x4 sacc = pp[64 * j];
                        for (int ks = 1; ks < nks; ++ks) sacc += pp[(size_t)ks * 65536 + 64 * j];
                        v[j] += (*(const f32x4*)(pg + 4 * lane + 256 * j) * pgs) * sacc; xr[64 * j] = v[j]; }
                }
#pragma unroll
                for (int j = 0; j < 4; ++j) ss += (v[j].x * v[j].x + v[j].y * v[j].y) + (v[j].z * v[j].z + v[j].w * v[j].w);
                const float rstd = rsqrtf(wave_sum(ss) * (1.f / 1024.f) + EPS);
                const float* mv = MODV + (size_t)(layer * 2 + (m >= T ? 1 : 0)) * 9216 + subl * 3072;
                const float* gp = P.norm_g + (layer * 3 + subl) * 1024;
                bf16_t* orow = H + (size_t)m * 1024;
                f32x4 gg[4], sh[4], sc[4];
#pragma unroll
                for (int j = 0; j < 4; ++j) { const int col = 4 * lane + 256 * j; gg[j] = *(const f32x4*)(gp + col); sh[j] = *(const f32x4*)(mv + col); sc[j] = *(const f32x4*)(mv + 1024 + col); }
#pragma unroll
                for (int j = 0; j < 4; ++j) { const int col = 4 * lane + 256 * j;
                    const f32x4 o = (v[j] * rstd) * gg[j] * (sc[j] + 1.f) + sh[j];
                    u32x2 w; w.x = pk2(o.x, o.y); w.y = pk2(o.z, o.w); *(u32x2*)(orow + col) = w; }
            }
        } else if (op == OP_CONV_GATE) {
            const float* ck = P.conv_k + (size_t)a * 3 * 1024;
            for (int idx = gtid; idx < M * 128; idx += NTALL) {
                const int m = idx >> 7, c8 = (idx & 127) * 8;
                const bf16_t* row = BIG + (size_t)m * 3072;
                const bool hasp = (m != 0) && (m != T), hasn = (m != T - 1) && (m != MT - 1);
                const u32x4 z = {0u, 0u, 0u, 0u};
                const u32x4 bg = *(const u32x4*)(row + c8);
                const u32x4 cg1 = *(const u32x4*)(row + 1024 + c8), xv1 = *(const u32x4*)(row + 2048 + c8);
                const u32x4 cg0 = hasp ? *(const u32x4*)(row - 3072 + 1024 + c8) : z, xv0 = hasp ? *(const u32x4*)(row - 3072 + 2048 + c8) : z;
                const u32x4 cg2 = hasn ? *(const u32x4*)(row + 3072 + 1024 + c8) : z, xv2 = hasn ? *(const u32x4*)(row + 3072 + 2048 + c8) : z;
                float o[8];
#pragma unroll
                for (int q = 0; q < 4; ++q) {
                    const float k0a = ck[c8 + 2 * q], k0b = ck[c8 + 2 * q + 1], k1a = ck[1024 + c8 + 2 * q], k1b = ck[1024 + c8 + 2 * q + 1], k2a = ck[2048 + c8 + 2 * q], k2b = ck[2048 + c8 + 2 * q + 1];
                    o[2 * q]     = blo(bg[q]) * (k0a * (blo(cg0[q]) * blo(xv0[q])) + k1a * (blo(cg1[q]) * blo(xv1[q])) + k2a * (blo(cg2[q]) * blo(xv2[q])));
                    o[2 * q + 1] = bhi(bg[q]) * (k0b * (bhi(cg0[q]) * bhi(xv0[q])) + k1b * (bhi(cg1[q]) * bhi(xv1[q])) + k2b * (bhi(cg2[q]) * bhi(xv2[q])));
                }
                u32x4 w; w.x = pk2(o[0], o[1]); w.y = pk2(o[2], o[3]); w.z = pk2(o[4], o[5]); w.w = pk2(o[6], o[7]);
                *(u32x4*)(U + (size_t)m * 1024 + c8) = w;
            }
        } else if (op == OP_ROPE) {
            const int s = lane >> 5, i = lane & 31;
            const float inv = exp2f(-(float)i * (13.287712379549449f / 32.f));
            for (int m = gw; m < MT; m += NGW) {
                bf16_t* row = BIG + (size_t)m * 1536;
                float cs = 1.f, sn = 0.f;
                if (m < T) { const float pos = s ? (float)(m & 63) : (float)(m >> 6); const float ang = pos * inv; float rev = ang * 0.15915494309189535f; rev -= floorf(rev);
                    cs = __builtin_amdgcn_cosf(rev); sn = __builtin_amdgcn_sinf(rev); }
                float x1[10], x2[10];
#pragma unroll
                for (int hs = 0; hs < 10; ++hs) { const bf16_t* hp = row + hs * 128 + s * 64 + i; x1[hs] = bf2f(hp[0]); x2[hs] = bf2f(hp[32]); }
                const float gq1 = P.q_g[s * 64 + i], gq2 = P.q_g[s * 64 + 32 + i], gk1 = P.k_g[s * 64 + i], gk2 = P.k_g[s * 64 + 32 + i];
#pragma unroll
                for (int hs = 0; hs < 10; ++hs) {
                    bf16_t* hp = row + hs * 128 + s * 64 + i;
                    const float rstd = rsqrtf(wave_sum(x1[hs] * x1[hs] + x2[hs] * x2[hs]) * (1.f / 128.f) + EPS);
                    const float y1 = x1[hs] * rstd * (hs < 8 ? gq1 : gk1), y2 = x2[hs] * rstd * (hs < 8 ? gq2 : gk2);
                    hp[0] = (bf16_t)f2bf(y1 * cs - y2 * sn); hp[32] = (bf16_t)f2bf(y2 * cs + y1 * sn);
                }
            }
        } else if (op == OP_ATT) {
            for (int it = bid; it < 520; it += G) {
                const bf16_t *Qp, *Kp, *Vp; bf16_t* Op; int seq;
                if (it < 512) { const int h = it >> 6, qb = it & 63; Qp = BIG + (size_t)(qb * 256) * 1536 + h * 128; Kp = BIG + 1024 + (h >> 2) * 128; Vp = BIG + 1280 + (h >> 2) * 128;
                    Op = U + (size_t)(qb * 256) * 1024 + h * 128; seq = MT; }
                else { const int h = it - 512; Qp = BIG + (size_t)T * 1536 + h * 128; Kp = BIG + (size_t)T * 1536 + 1024 + (h >> 2) * 128; Vp = BIG + (size_t)T * 1536 + 1280 + (h >> 2) * 128;
                    Op = U + (size_t)T * 1024 + h * 128; seq = TC; }
                att::attn_dense_body(Qp, Kp, Op, seq, (char*)smem, tid);
                __syncthreads();
            }
        } else if (op == OP_ML_IN) {
            float* sW = (float*)smem;
            { float tw[32];
#pragma unroll
              for (int q = 0; q < 32; ++q) { const int i = tid + q * NTHREADS; tw[q] = P.ml_in[(size_t)(i >> 4) * 3088 + 1536 + (i & 15)]; }
#pragma unroll
              for (int q = 0; q < 32; ++q) sW[tid + q * NTHREADS] = tw[q]; }
            __syncthreads();
            const int gq = tid & 15, tl = tid >> 4;
            const int nbusy = (MT / 256) * 12 - 3 * G;
            const int g0 = (nbusy > 0 && nbusy < G) ? nbusy : 0;
            if (bid >= g0) for (int grp = bid - g0; grp < MT / 32; grp += G - g0) {
                const int m = grp * 32 + tl; const u32x4* hp = (const u32x4*)(H + (size_t)m * 1024); float acc = 0.f;
#pragma unroll 16
                for (int kk = 0; kk < 128; ++kk) { const u32x4 hv = hp[kk]; const float* wp = sW + (kk * 8) * 16 + gq;
                    acc += blo(hv.x) * wp[0] + bhi(hv.x) * wp[16] + blo(hv.y) * wp[32] + bhi(hv.y) * wp[48] + blo(hv.z) * wp[64] + bhi(hv.z) * wp[80] + blo(hv.w) * wp[96] + bhi(hv.w) * wp[112]; }
                GATES[(size_t)m * 16 + gq] = acc + P.ml_b[gq];
            }
            __syncthreads();
        } else if (op == OP_ML_STATE) {
            char* sVt = (char*)smem; char* sKt = (char*)smem + 32768; float* sa = (float*)(smem + 131072); float* sw = sa + 256;
            const int r32 = lane & 31, hi = lane >> 5;
            for (int it = bid; it < 64 * 8; it += G) {
                const int c = it >> 3, hd = it & 7, dir = hd >> 2, head = hd & 3;
                __syncthreads();
                float av = 0.f, igv = 0.f;
                if (tid < 256) { const int m = ml_tok(dir, c, tid); const float* gp = GATES + (size_t)m * 16; av = logsigf(gp[(2 * dir + 1) * 4 + head]); igv = gp[(2 * dir) * 4 + head]; }
                int tsc_ = tid; asm volatile("" : "+v"(tsc_)); float Aend; const float Ar = block_scan256(av, sa, tsc_, Aend);
                if (tid < 256) sw[tid] = __expf(Aend - Ar + igv) * 0.08838834764831845f;
                f32x16 acc[4] = {}; float nacc = 0.f;
                const int vbase = (int)(uintptr_t)sVt + (wave >> 2) * 16384 + (wave & 3) * 512 + att::v_rd_base(lane);
                const int kbase = (int)(uintptr_t)sKt + att::v_rd_base(lane);
                const int sr = tid >> 4, sc = (tid & 15) * 8;
                for (int kt = 0; kt < 4; ++kt) {
                    __syncthreads();
#pragma unroll
                    for (int h2 = 0; h2 < 2; ++h2) {
                        const int row = h2 * 32 + sr, s = kt * 64 + row; const int m = ml_tok(dir, c, s); const bf16_t* rowp = BIG + (size_t)m * 3072;
                        const u32x4 v0 = *(const u32x4*)(rowp + 512 + head * 256 + sc), v1 = *(const u32x4*)(rowp + 512 + head * 256 + 128 + sc), kk = *(const u32x4*)(rowp + head * 128 + sc);
                        const float wsc = sw[s];
                        u32x4 ks; ks.x = pk2(blo(kk.x) * wsc, bhi(kk.x) * wsc); ks.y = pk2(blo(kk.y) * wsc, bhi(kk.y) * wsc); ks.z = pk2(blo(kk.z) * wsc, bhi(kk.z) * wsc); ks.w = pk2(blo(kk.w) * wsc, bhi(kk.w) * wsc);
                        const int off = att::v_st(row, sc);
                        *(u32x4*)(sVt + off) = v0; *(u32x4*)(sVt + 16384 + off) = v1; *(u32x4*)(sKt + off) = ks;
                    }
                    __syncthreads();
                    if (tid < 128) { for (int s = 0; s < 64; ++s) nacc += bf2f(*(const bf16_t*)(sKt + att::v_st(s, tid & ~7) + (tid & 7) * 2)); }
#define ML_FR(base, D0, KS) ({ const s16x4 l_ = att::tr_read<att::v_rd_off(D0, KS, 0)>(base), h_ = att::tr_read<att::v_rd_off(D0, KS, 1)>(base); (bf16x8){l_[0], l_[1], l_[2], l_[3], h_[0], h_[1], h_[2], h_[3]}; })
#define ML_KS(KS) do { bf16x8 a_ = ML_FR(vbase, 0, KS), b0_ = ML_FR(kbase, 0, KS), b1_ = ML_FR(kbase, 1, KS), b2_ = ML_FR(kbase, 2, KS), b3_ = ML_FR(kbase, 3, KS); \
                        asm volatile("s_waitcnt lgkmcnt(0)" ::: "memory"); __builtin_amdgcn_sched_barrier(0); \
                        acc[0] = __builtin_amdgcn_mfma_f32_32x32x16_bf16(a_, b0_, acc[0], 0, 0, 0); acc[1] = __builtin_amdgcn_mfma_f32_32x32x16_bf16(a_, b1_, acc[1], 0, 0, 0); \
                        acc[2] = __builtin_amdgcn_mfma_f32_32x32x16_bf16(a_, b2_, acc[2], 0, 0, 0); acc[3] = __builtin_amdgcn_mfma_f32_32x32x16_bf16(a_, b3_, acc[3], 0, 0, 0); } while (0)
                    ML_KS(0); ML_KS(1); ML_KS(2); ML_KS(3);
#undef ML_KS
                }
                float* UT = ST + (size_t)(c * 8 + hd) * 32768;
#pragma unroll
                for (int db = 0; db < 4; ++db)
#pragma unroll
                    for (int r = 0; r < 16; ++r) UT[(32 * wave + att::crow(r, hi)) * 128 + 32 * db + r32] = acc[db][r];
                if (tid < 128) STN[(c * 8 + hd) * 128 + tid] = nacc;
                if (tid == 0) DEC[c * 8 + hd] = __expf(Aend);
            }
            __syncthreads();
        } else if (op == OP_ML_SCAN) {
            bf16_t* CTb = (bf16_t*)(ws + OFF_CTB);
            for (int e = gtid; e < 8 * 32768 + 8 * 128; e += NTALL) {
                const bool mat = e < 8 * 32768;
                const int hd = mat ? (e >> 15) : ((e - 8 * 32768) >> 7), idx = mat ? (e & 32767) : ((e - 8 * 32768) & 127);
                float* p = mat ? (ST + (size_t)hd * 32768 + idx) : (STN + hd * 128 + idx);
                const size_t cs = mat ? (size_t)8 * 32768 : (size_t)8 * 128;
                bf16_t* cb = CTb + (size_t)hd * 32768 + idx;
                const float* dp = DEC + hd;
                float run = 0.f;
                for (int half = 0; half < 2; ++half) {
                    float uv[32], dc[32];
                    { const float* pl = p;
#pragma unroll
                      for (int c = 0; c < 32; ++c) { uv[c] = *pl; pl += cs; dc[c] = dp[c * 8]; } }
#pragma unroll
                    for (int c = 0; c < 32; ++c) { *p = run; if (mat) *cb = (bf16_t)f2bf(run); run = dc[c] * run + uv[c]; p += cs; cb += (size_t)8 * 32768; }
                    dp += 32 * 8;
                }
                *p = run; if (mat) *cb = (bf16_t)f2bf(run);
            }
        } else if (op == OP_ML_OUT) {
            const bf16_t* CTb = (const bf16_t*)(ws + OFF_CTB);
            char* sK = (char*)smem; char* sV = (char*)smem + 65536;
            float* sA0 = (float*)(smem + 131072); float* sB0 = sA0 + 256; float* sA1 = sB0 + 256; float* sB1 = sA1 + 256; float* sN0 = sB1 + 256; float* sN1 = sN0 + 128;
            float* sInv0 = sN1 + 128; float* sInv1 = sInv0 + 256; float* wtot = sInv1 + 256;
            for (int it = bid; it < 256; it += G) {
                const int j = it >> 2, head = it & 3;
                __syncthreads();
                {
                    float av0 = 0.f, ig0 = 0.f, av1 = 0.f, ig1 = 0.f;
                    int tsc_ = tid; asm volatile("" : "+v"(tsc_));
                    if (tsc_ < 256) { const float* g0 = GATES + (size_t)(256 * j + tsc_) * 16; const float* g1 = GATES + (size_t)(256 * j + 255 - tsc_) * 16;
                        av0 = logsigf(g0[4 + head]); ig0 = g0[head]; av1 = logsigf(g1[12 + head]); ig1 = g1[8 + head]; }
                    else if (tsc_ < 384) sN0[tsc_ - 256] = STN[((j + 1) * 8 + head) * 128 + (tsc_ - 256)];
                    else sN1[tsc_ - 384] = STN[((64 - j) * 8 + 4 + head) * 128 + (tsc_ - 384)];
                    float tot0, tot1; const float Ar0 = block_scan256(av0, wtot, tsc_, tot0); const float Ar1 = block_scan256(av1, wtot + 4, tsc_, tot1);
                    if (tsc_ < 256) { sA0[tsc_] = Ar0; sB0[tsc_] = ig0 - Ar0; sA1[255 - tsc_] = Ar1; sB1[255 - tsc_] = ig1 - Ar1; }
                }
                { int tk_ = tid; asm volatile("" : "+v"(tk_)); const int sr = tk_ >> 4, sc = (tk_ & 15) * 8;
#pragma unroll
                  for (int kt = 0; kt < 4; ++kt)
#pragma unroll
                      for (int h2 = 0; h2 < 2; ++h2) { const int row = h2 * 32 + sr; const int m = 256 * j + kt * 64 + row;
                          *(u32x4*)(sK + kt * 16384 + KSWZ(row, sc * 2)) = *(const u32x4*)(BIG + (size_t)m * 3072 + head * 128 + sc); } }
                __syncthreads();
                int tq_ = tid; asm volatile("" : "+v"(tq_));
                const int r32 = tq_ & 31, hi = (tq_ >> 5) & 1;
                const int rq = 32 * wave + r32; const int mq = 256 * j + rq;
                bf16x8 qr[8];
                const float At0 = sA0[rq], At1 = sA1[rq], ea0 = __expf(At0), ea1 = __expf(At1);
                float qn0 = 0.f, qn1 = 0.f;
#pragma unroll
                for (int d0 = 0; d0 < 8; ++d0) {
                    const u32x4 qq = *(const u32x4*)(BIG + (size_t)mq * 3072 + 1536 + head * 128 + hi * 8 + d0 * 16);
                    qr[d0] = *(const bf16x8*)&qq;
                    const float* n0 = sN0 + d0 * 16 + hi * 8; const float* n1 = sN1 + d0 * 16 + hi * 8;
                    qn0 += blo(qq.x) * n0[0] + bhi(qq.x) * n0[1] + blo(qq.y) * n0[2] + bhi(qq.y) * n0[3] + blo(qq.z) * n0[4] + bhi(qq.z) * n0[5] + blo(qq.w) * n0[6] + bhi(qq.w) * n0[7];
                    qn1 += blo(qq.x) * n1[0] + bhi(qq.x) * n1[1] + blo(qq.y) * n1[2] + bhi(qq.y) * n1[3] + blo(qq.z) * n1[4] + bhi(qq.z) * n1[5] + blo(qq.w) * n1[6] + bhi(qq.w) * n1[7];
                }
                { auto rr = __builtin_amdgcn_permlane32_swap(__float_as_uint(qn0), __float_as_uint(qn0), false, false); qn0 = (__uint_as_float(rr[0]) + __uint_as_float(rr[1])) * ea0; }
                { auto rr = __builtin_amdgcn_permlane32_swap(__float_as_uint(qn1), __float_as_uint(qn1), false, false); qn1 = (__uint_as_float(rr[0]) + __uint_as_float(rr[1])) * ea1; }
                for (int vh = 0; vh < 2; ++vh) {
                    __syncthreads();
                    { int tv_ = tid; asm volatile("" : "+v"(tv_)); const int sr = tv_ >> 4, sc = (tv_ & 15) * 8;
#pragma unroll
                      for (int kt = 0; kt < 4; ++kt)
#pragma unroll
                          for (int h2 = 0; h2 < 2; ++h2) { const int row = h2 * 32 + sr; const int m = 256 * j + kt * 64 + row;
                              *(u32x4*)(sV + kt * 16384 + att::v_st(row, sc)) = *(const u32x4*)(BIG + (size_t)m * 3072 + 512 + head * 256 + vh * 128 + sc); } }
                    __syncthreads();
                    for (int dir = 0; dir < 2; ++dir) {
                        const int c = dir ? (64 - j) : (j + 1), hd = dir * 4 + head;
                        const float At = dir ? At1 : At0, ea = dir ? ea1 : ea0; const float* sB = dir ? sB1 : sB0; float* sInv = dir ? sInv1 : sInv0;
                        f32x16 o[4] = {};
                        {
                            const bf16_t* CT = CTb + (size_t)(c * 8 + hd) * 32768 + (size_t)(vh * 128 + r32) * 128 + hi * 8;
#pragma unroll
                            for (int d0 = 0; d0 < 8; ++d0) {
                                const u32x4 qq = *(const u32x4*)&qr[d0];
                                u32x4 qv; qv.x = cvt_pk_bf16(blo(qq.x) * ea, bhi(qq.x) * ea); qv.y = cvt_pk_bf16(blo(qq.y) * ea, bhi(qq.y) * ea); qv.z = cvt_pk_bf16(blo(qq.z) * ea, bhi(qq.z) * ea); qv.w = cvt_pk_bf16(blo(qq.w) * ea, bhi(qq.w) * ea);
                                const bf16x8 qsd = *(const bf16x8*)&qv;
                                const bf16x8 b0 = att::ld8(CT + 0 * 4096 + d0 * 16), b1 = att::ld8(CT + 1 * 4096 + d0 * 16), b2 = att::ld8(CT + 2 * 4096 + d0 * 16), b3 = att::ld8(CT + 3 * 4096 + d0 * 16);
                                o[0] = __builtin_amdgcn_mfma_f32_32x32x16_bf16(qsd, b0, o[0], 0, 0, 0); o[1] = __builtin_amdgcn_mfma_f32_32x32x16_bf16(qsd, b1, o[1], 0, 0, 0);
                                o[2] = __builtin_amdgcn_mfma_f32_32x32x16_bf16(qsd, b2, o[2], 0, 0, 0); o[3] = __builtin_amdgcn_mfma_f32_32x32x16_bf16(qsd, b3, o[3], 0, 0, 0);
                                if ((d0 & 3) == 3) __builtin_amdgcn_sched_barrier(0);
                            }
                        }
                        float nsum = 0.f;
                        int tl_ = tid; asm volatile("" : "+v"(tl_)); const int vb0 = (int)(uintptr_t)sV + att::v_rd_base(tl_ & 63);
                        const int kt0 = dir ? (wave >> 1) : 0, kt1 = dir ? 4 : ((wave >> 1) + 1);
                        for (int kt = kt0; kt < kt1; ++kt) {
                            f32x16 p0, p1;
                            att::qkt(p0, p1, (const bf16_t*)(sK + kt * 16384), qr, r32, hi);
#pragma unroll
                            for (int r = 0; r < 16; ++r) { const int s0 = kt * 64 + att::crow(r, hi), s1 = s0 + 32;
                                const bool k0 = dir ? (s0 >= rq) : (s0 <= rq), k1 = dir ? (s1 >= rq) : (s1 <= rq);
                                p0[r] = k0 ? p0[r] * __expf(At + sB[s0]) * 0.08838834764831845f : 0.f;
                                p1[r] = k1 ? p1[r] * __expf(At + sB[s1]) * 0.08838834764831845f : 0.f;
                                nsum += p0[r] + p1[r]; }
                            bf16x8 pa0, pa1, pa2, pa3;
                            att::pk_p(p0, p1, pa0, pa1, pa2, pa3);
                            att::pv_d0(o, vb0 + kt * 16384, pa0, pa1, pa2, pa3);
                        }
                        if (vh == 0) {
                            auto rr = __builtin_amdgcn_permlane32_swap(__float_as_uint(nsum), __float_as_uint(nsum), false, false);
                            const float Nt = __uint_as_float(rr[0]) + __uint_as_float(rr[1]) + (dir ? qn1 : qn0); const float invn = 1.f / fmaxf(fabsf(Nt), 1.f);
                            if (hi == 0) sInv[wave * 32 + r32] = invn;
                            asm volatile("s_waitcnt lgkmcnt(0)" ::: "memory");
                        }
                        int ts_ = tid; asm volatile("" : "+v"(ts_)); const int r32s = ts_ & 31, his = (ts_ >> 5) & 1;
                        if (dir == 0) {
#pragma unroll
                            for (int r = 0; r < 16; ++r) { const int m = 256 * j + 32 * wave + att::crow(r, his); const float ri = sInv[wave * 32 + att::crow(r, his)];
                                float* hp = HH + (size_t)m * 1024 + head * 256 + vh * 128 + r32s;
#pragma unroll
                                for (int d0 = 0; d0 < 4; ++d0) hp[d0 * 32] = o[d0][r] * ri; }
                        } else {
#pragma unroll
                            for (int rh = 0; rh < 4; ++rh) {
                                float prev[4][4];
#pragma unroll
                                for (int r8 = 0; r8 < 4; ++r8) { const int r = rh * 4 + r8; const int m = 256 * j + 32 * wave + att::crow(r, his);
                                    const float* hp = HH + (size_t)m * 1024 + head * 256 + vh * 128 + r32s;
#pragma unroll
                                    for (int d0 = 0; d0 < 4; ++d0) prev[r8][d0] = hp[d0 * 32]; }
#pragma unroll
                                for (int r8 = 0; r8 < 4; ++r8) { const int r = rh * 4 + r8; const int m = 256 * j + 32 * wave + att::crow(r, his); const float ri = sInv[wave * 32 + att::crow(r, his)];
                                    float* hp = HH + (size_t)m * 1024 + head * 256 + vh * 128 + r32s;
#pragma unroll
                                    for (int d0 = 0; d0 < 4; ++d0) hp[d0 * 32] = prev[r8][d0] + o[d0][r] * ri; }
                            }
                        }
                    }
                }
                __syncthreads();
                for (int ib = 0; ib < 8; ++ib) {
                    int tf_ = tid; asm volatile("" : "+v"(tf_));
                    const int tt = (tf_ >> 4) + 32 * ib, vq = tf_ & 15; const int m = 256 * j + tt;
                    const float* hp = HH + (size_t)m * 1024 + head * 256 + vq * 16;
                    float hh[16]; float ss = 0.f;
#pragma unroll
                    for (int q = 0; q < 4; ++q) { const f32x4 h0 = *(const f32x4*)(hp + 4 * q); hh[4 * q] = h0.x; hh[4 * q + 1] = h0.y; hh[4 * q + 2] = h0.z; hh[4 * q + 3] = h0.w; }
#pragma unroll
                    for (int q = 0; q < 16; ++q) ss += hh[q] * hh[q];
                    ss += __shfl_xor(ss, 1); ss += __shfl_xor(ss, 2); ss += __shfl_xor(ss, 4); ss += __shfl_xor(ss, 8);
                    const float rstd = rsqrtf(ss * (1.f / 256.f) + EPS);
                    const float* gn = P.ml_g + head * 256 + vq * 16;
                    const u32x4* op_ = (const u32x4*)(BIG + (size_t)m * 3072 + 2048 + head * 256 + vq * 16); const u32x4 o0 = op_[0], o1 = op_[1];
                    const float ov[16] = {blo(o0.x), bhi(o0.x), blo(o0.y), bhi(o0.y), blo(o0.z), bhi(o0.z), blo(o0.w), bhi(o0.w), blo(o1.x), bhi(o1.x), blo(o1.y), bhi(o1.y), blo(o1.z), bhi(o1.z), blo(o1.w), bhi(o1.w)};
                    float y[16];
#pragma unroll
                    for (int q = 0; q < 16; ++q) y[q] = sigmf(ov[q]) * (hh[q] * rstd * gn[q]);
                    u32x4 w0, w1; w0.x = pk2(y[0], y[1]); w0.y = pk2(y[2], y[3]); w0.z = pk2(y[4], y[5]); w0.w = pk2(y[6], y[7]);
                    w1.x = pk2(y[8], y[9]); w1.y = pk2(y[10], y[11]); w1.z = pk2(y[12], y[13]); w1.w = pk2(y[14], y[15]);
                    u32x4* up = (u32x4*)(U + (size_t)m * 1024 + head * 256 + vq * 16); up[0] = w0; up[1] = w1;
                }
            }
        }
        if (ph + 1 < P.nprog) { if (P.nprog < 0) grid.sync();   xcd_barrier(xbar, tid == 0); if (PROBE & 8) xcd_barrier(xbar, tid == 0); }
    }
}

extern "C" void kernel_launch(void* const* d_in, const int* in_sizes, int n_in, void* d_out, int out_size, void* d_ws, size_t ws_size, hipStream_t stream) {
    static int grid_blocks = 0;
    if (grid_blocks == 0) {
        if (n_in != 20 || ws_size < WS_END || out_size != T * DM) { fprintf(stderr, "kernel_launch: unexpected shapes: n_in %d ws %zu (need %zu) out %d\n", n_in, ws_size, (size_t)WS_END, out_size); grid_blocks = -1; return; }
        int dev = 0, cus = 0, per_cu = 0;
        hipGetDevice(&dev);
        hipDeviceGetAttribute(&cus, hipDeviceAttributeMultiprocessorCount, dev);
        if (hipFuncSetAttribute((const void*)fwd_megakernel, hipFuncAttributeMaxDynamicSharedMemorySize, LDS_BYTES) != hipSuccess) { fprintf(stderr, "kernel_launch: hipFuncSetAttribute failed\n"); grid_blocks = -1; return; }
        if (hipOccupancyMaxActiveBlocksPerMultiprocessor(&per_cu, (const void*)fwd_megakernel, NTHREADS, LDS_BYTES) != hipSuccess || per_cu < 1) { fprintf(stderr, "kernel_launch: occupancy query gave %d\n", per_cu); per_cu = 1; }
        (void)hipGetLastError();
        grid_blocks = cus * per_cu;
    }
    if (grid_blocks < 0) return;
    Params p{};
    const float** pp[20] = {&p.x, &p.c, &p.ctx, &p.cctx, &p.mod_w, &p.mod_b, &p.norm_g, &p.w13, &p.w2, &p.conv_in, &p.conv_k, &p.conv_out, &p.qkv, &p.q_g, &p.k_g, &p.attn_o, &p.ml_in, &p.ml_b, &p.ml_g, &p.ml_o};
    for (int i = 0; i < 20; ++i) *pp[i] = (const float*)d_in[i];
    p.out = (float*)d_out; p.ws = (unsigned char*)d_ws;
    int n = 0;
    auto add = [&](int op, int layer, int a, int M) { p.prog[n][0] = op; p.prog[n][1] = layer; p.prog[n][2] = a; p.prog[n][3] = M; ++n; };
    add(OP_PREP, 0, 0, 0); if (PROBE & 16) add(OP_PREP, 0, 0, 0);
    int pend = 0;
    auto addmod = [&](int layer, int sub, int M) { add(OP_MOD, layer, sub | (M == MT ? pend : 0) | ((layer == 0 && sub == 0) ? (1 << 28) : 0) | ((layer == 0 && sub == 1) ? (1 << 29) : 0), M); pend = 0; };
    auto addres = [&](int op, int layer, int a, int M, int K, int sub, int half) { if ((PROBE & 64) && op == OP_W2) add(op, layer, (a & 1) | 4, T); add(op, layer, a, M); if (M == MT) pend = ((K / 256) << 4) | (sub << 12) | (layer << 16) | (half << 24); };
    int cnt[3] = {0, 0, 0};
    for (int layer = 0; layer < 4; ++layer) {
        const int kind = layer % 3, j = cnt[kind]++;
        const bool ctx_in = layer <= 2, ctx_out = layer <= 1;
        const int Min = ctx_in ? MT : T, Mout = ctx_out ? MT : T;
        addmod(layer, 0, Min); add(OP_W13, layer, 0, Min); if (PROBE & 32) add(OP_W13, layer, 0, Min); if (PROBE & 128) add(OP_W13, layer, 8, Min); addres(OP_W2, layer, (layer == 0 ? 16 : 0), Min, 2816, 0, 1);
        addmod(layer, 1, Min);
        if (kind == 0) { add(OP_CONV_IN, layer, j, Mout); if (PROBE & 256) add(OP_CONV_IN, layer, j, Mout); add(OP_CONV_GATE, layer, j, Mout); addres(OP_CONV_OUT, layer, j, Mout, 1024, 1, 0); }
        else if (kind == 1) { add(OP_QKV, layer, 0, MT); if (PROBE & 256) add(OP_QKV, layer, 0, MT); add(OP_ROPE, layer, 0, MT); if (PROBE & 512) { add(OP_QKV, layer, 0, MT); add(OP_ROPE, layer, 0, MT); } add(OP_ATT, layer, 0, MT); if (PROBE & 2) add(OP_ATT, layer, 0, MT); addres(OP_ATT_OUT, layer, 0, Mout, 1024, 1, 0); }
        else { add(OP_ML_IN, layer, 0, MT); if (PROBE & 256) add(OP_ML_IN, layer, 0, MT); add(OP_ML_STATE, layer, 0, 0); if (PROBE & 1) add(OP_ML_STATE, layer, 0, 0); add(OP_ML_SCAN, layer, 0, 0); add(OP_ML_OUT, layer, 0, 0); if (PROBE & 1) add(OP_ML_OUT, layer, 0, 0); add(OP_ML_PROJ, layer, 0, T); }
        addmod(layer, 2, Mout); add(OP_W13, layer, 1, Mout); if (PROBE & 32) add(OP_W13, layer, 1, Mout); if (PROBE & 128) add(OP_W13, layer, 9, Mout); addres(OP_W2, layer, 1 | (layer == 3 ? 2 : 0), Mout, 2816, 2, 1);
    }
    p.nprog = n;
    if (hipMemsetAsync((char*)d_ws + OFF_BAR, 0, 16384, stream) != hipSuccess) { fprintf(stderr, "kernel_launch: memset failed\n"); return; }
    void* args[] = {&p};
    hipError_t e = hipLaunchCooperativeKernel((const void*)fwd_megakernel, dim3(grid_blocks), dim3(NTHREADS), args, LDS_BYTES, stream);
    if (e != hipSuccess) fprintf(stderr, "cooperative launch failed: %s (grid %d)\n", hipGetErrorString(e), grid_blocks);
}
```

```cpp
#include <hip/hip_runtime.h>
#include <hip/hip_cooperative_groups.h>
#include <cstdio>
#include <cstdint>
namespace cg = cooperative_groups;

#define LAS __attribute__((address_space(3)))
typedef unsigned short bf16_t;
typedef short bf16x8 __attribute__((ext_vector_type(8)));
typedef short s16x4 __attribute__((ext_vector_type(4)));
typedef float f32x4 __attribute__((ext_vector_type(4)));
typedef float f32x16 __attribute__((ext_vector_type(16)));
typedef unsigned u32x4 __attribute__((ext_vector_type(4)));
typedef unsigned u32x2 __attribute__((ext_vector_type(2)));

constexpr int DM = 1024, T = 16384, TC = 256, MT = T + TC, FF = 2816;
constexpr float EPS = 1e-6f;
constexpr int NTHREADS = 512, NWAVES = 8;
constexpr int LDS_BYTES = 131072 + 8192;
#ifndef PROBE
#define PROBE 0
#endif

constexpr size_t SZ_W13T = (size_t)8 * 5632 * 1024 * 2, SZ_W2T = (size_t)8 * 1024 * 2816 * 2, SZ_CINT = (size_t)2 * 3072 * 1024 * 2, SZ_COUTT = (size_t)2 * 1024 * 1024 * 2;
constexpr size_t SZ_QKVT = (size_t)1536 * 1024 * 2, SZ_SQ = (size_t)1024 * 1024 * 2, SZ_MLINT = (size_t)3072 * 1024 * 2;
constexpr size_t OFF_W13T = 0, OFF_W2T = OFF_W13T + SZ_W13T, OFF_CINT = OFF_W2T + SZ_W2T, OFF_COUTT = OFF_CINT + SZ_CINT, OFF_QKVT = OFF_COUTT + SZ_COUTT,
                 OFF_AOT = OFF_QKVT + SZ_QKVT, OFF_MLINT = OFF_AOT + SZ_SQ, OFF_MLOT = OFF_MLINT + SZ_MLINT, OFF_X = OFF_MLOT + SZ_SQ,
                 OFF_H = OFF_X + (size_t)MT * 1024 * 4, OFF_U = OFF_H + (size_t)MT * 1024 * 2, OFF_BIG = OFF_U + (size_t)MT * 1024 * 2,
                 OFF_MODV = OFF_BIG + (size_t)MT * 3072 * 2, OFF_GATES = OFF_MODV + (size_t)4 * 2 * 9216 * 4, OFF_ST = OFF_GATES + (size_t)MT * 16 * 4,
                 OFF_STN = OFF_ST + (size_t)65 * 8 * 32768 * 4, OFF_DEC = OFF_STN + (size_t)65 * 8 * 128 * 4, OFF_HH = OFF_DEC + 4096,
                 OFF_BAR = OFF_HH + (size_t)T * 1024 * 4, OFF_CTB = OFF_BAR + 16384, OFF_PART = OFF_CTB + (size_t)65 * 8 * 32768 * 2, WS_END = OFF_PART + (size_t)11 * 256 * 1024 * 4;
static_assert(WS_END <= (size_t)603979776, "workspace");

enum { OP_PREP = 0, OP_MOD, OP_W13, OP_W2, OP_CONV_IN, OP_CONV_GATE, OP_CONV_OUT, OP_QKV, OP_ROPE, OP_ATT, OP_ATT_OUT, OP_ML_IN, OP_ML_STATE, OP_ML_SCAN, OP_ML_OUT, OP_ML_PROJ };
struct Params {
    const float *x, *c, *ctx, *cctx, *mod_w, *mod_b, *norm_g, *w13, *w2, *conv_in, *conv_k, *conv_out, *qkv, *q_g, *k_g, *attn_o, *ml_in, *ml_b, *ml_g, *ml_o;
    float* out; unsigned char* ws;
    int nprog, pad;
    int prog[64][4];
};

__device__ __forceinline__ unsigned f2bf(float f) { unsigned u = __float_as_uint(f); return (u + 0x7fffu + ((u >> 16) & 1u)) >> 16; }
__device__ __forceinline__ unsigned pk2(float lo, float hi) { return f2bf(lo) | (f2bf(hi) << 16); }
__device__ __forceinline__ float bf2f(bf16_t b) { return __uint_as_float(((unsigned)b) << 16); }
__device__ __forceinline__ float blo(unsigned w) { return __uint_as_float(w << 16); }
__device__ __forceinline__ float bhi(unsigned w) { return __uint_as_float(w & 0xffff0000u); }
__device__ __forceinline__ float wave_sum(float v) {
#pragma unroll
    for (int o = 1; o < 64; o <<= 1) v += __shfl_xor(v, o);
    return v;
}
__device__ __forceinline__ float siluf(float x) { return x * __builtin_amdgcn_rcpf(1.f + __expf(-x)); }
__device__ __forceinline__ float sigmf(float x) { return __builtin_amdgcn_rcpf(1.f + __expf(-x)); }
__device__ __forceinline__ float logsigf(float x) { return fminf(x, 0.f) - log1pf(__expf(-fabsf(x))); }
__device__ __forceinline__ unsigned cvt_pk_bf16(float lo, float hi) { unsigned r; asm volatile("v_cvt_pk_bf16_f32 %0, %1, %2" : "=v"(r) : "v"(lo), "v"(hi)); return r; }

namespace pg8 {
constexpr int BM = 256, BK = 64, HALF = 128, HTB = HALF * BK * 2, STAGE_BYTES = 8 * HTB, NXCD = 8, WGM = 8;
__device__ __forceinline__ int lds_byte(int r, int c) { const int st = (r >> 4) * 2 + (c >> 5), rr = r & 15, cc = c & 31, ob = rr * 64 + cc * 2; return st * 1024 + (ob ^ (((ob >> 9) & 1) << 5)); }
__device__ __forceinline__ void stage_rc(int b, int& R, int& C) { const int st = b / 1024, sb = b % 1024, swz = sb ^ (((sb >> 9) & 1) << 5); R = (st >> 1) * 16 + swz / 64; C = (st & 1) * 32 + (swz % 64) / 2; }
__device__ __forceinline__ int perm32(int rho) { const int n = rho >> 4, i = rho & 15; return 8 * (i >> 2) + 4 * n + (i & 3); }
struct Unit { int pm, pn; };
struct Gemm { const bf16_t* A; const bf16_t* Bt; int M, N, K, lda; };
struct StaticOrder {
    int nM, nN, nwg, G, c;
    __device__ void init(int M, int N, int G_, int c_) { nM = M / BM; nN = N / BM; nwg = nM * nN; G = G_; c = c_; }
    __device__ bool next(int i, Unit& u) const {
        const long L = (long)i * G + c; if (L >= nwg) return false;
        int wgid = (int)L; { const int q = nwg / NXCD, r = nwg % NXCD, xcd = wgid % NXCD, off = wgid / NXCD; wgid = (xcd < r ? xcd * (q + 1) : r * (q + 1) + (xcd - r) * q) + off; }
        const int nig = WGM * nN, gid = wgid / nig, fm = gid * WGM, gsz = (nM - fm) < WGM ? (nM - fm) : WGM;
        u.pm = fm + ((wgid % nig) % gsz); u.pn = (wgid % nig) / gsz; return true;
    }
    __device__ __forceinline__ size_t aoff(const Unit& u, size_t tstep) const { return (size_t)u.pm * tstep; }
    __device__ __forceinline__ size_t boff(const Unit& u, size_t tstep) const { return (size_t)u.pn * tstep; }
};
struct SplitOrder {
    int nsub, G, c;
    __device__ bool next(int i, Unit& u) const { const int L = i * G + c; if (L >= nsub) return false; u.pm = L >> 2; u.pn = L & 3; return true; }
    __device__ __forceinline__ size_t aoff(const Unit& u, size_t) const { return (size_t)u.pm * 512; }
    __device__ __forceinline__ size_t boff(const Unit& u, size_t tstep) const { return (size_t)u.pn * tstep + (size_t)u.pm * 512; }
};
struct EpiPart {
    static constexpr bool PERM = false;
    float* Pp;
    __device__ __forceinline__ void operator()(const f32x4 (&acc)[2][2][4][2], const Unit& u, int wr, int wc, int fr, int fq) const {
        const int row0 = wr * 64 + fr, col0 = u.pn * BM + wc * 32 + 4 * fq;
        float* base = Pp + (size_t)u.pm * 256 * 1024;
#pragma unroll
        for (int ai = 0; ai < 2; ++ai)
#pragma unroll
            for (int m = 0; m < 4; ++m) { float* rowp = base + (size_t)(row0 + ai * HALF + m * 16) * 1024 + col0;
#pragma unroll
                for (int bj = 0; bj < 2; ++bj)
#pragma unroll
                    for (int n = 0; n < 2; ++n) *(f32x4*)(rowp + bj * HALF + n * 16) = acc[ai][bj][m][n]; }
    }
};
struct EpiSwiglu {
    static constexpr bool PERM = true;
    bf16_t* O; int ldc;
    __device__ __forceinline__ void operator()(const f32x4 (&acc)[2][2][4][2], const Unit& u, int wr, int wc, int fr, int fq) const {
        const int row0 = u.pm * BM + wr * 64 + fr, col0 = u.pn * 128 + wc * 32 + 8 * fq;
#pragma unroll
        for (int ai = 0; ai < 2; ++ai)
#pragma unroll
            for (int m = 0; m < 4; ++m) { bf16_t* rowp = O + (size_t)(row0 + ai * HALF + m * 16) * ldc + col0;
                const f32x4 g0 = acc[ai][0][m][0], g1 = acc[ai][0][m][1], u0 = acc[ai][1][m][0], u1 = acc[ai][1][m][1];
                u32x4 w; w.x = cvt_pk_bf16(siluf(g0[0]) * u0[0], siluf(g0[1]) * u0[1]); w.y = cvt_pk_bf16(siluf(g0[2]) * u0[2], siluf(g0[3]) * u0[3]);
                w.z = cvt_pk_bf16(siluf(g1[0]) * u1[0], siluf(g1[1]) * u1[1]); w.w = cvt_pk_bf16(siluf(g1[2]) * u1[2], siluf(g1[3]) * u1[3]);
                __builtin_nontemporal_store(w, (u32x4*)rowp); }
    }
};
struct EpiResid {
    static constexpr bool PERM = false;
    const float* src; float* dst; const float* gate_lat; const float* gate_ctx; float gs;
    __device__ __forceinline__ void operator()(const f32x4 (&acc)[2][2][4][2], const Unit& u, int wr, int wc, int fr, int fq) const {
        const int row0 = u.pm * BM + wr * 64 + fr, col0 = u.pn * BM + wc * 32 + 4 * fq;
        const float* gt = (u.pm >= T / BM) ? gate_ctx : gate_lat;
        f32x4 gv[2][2];
#pragma unroll
        for (int bj = 0; bj < 2; ++bj)
#pragma unroll
            for (int n = 0; n < 2; ++n) gv[bj][n] = *(const f32x4*)(gt + col0 + bj * HALF + n * 16) * gs;
#pragma unroll
        for (int ai = 0; ai < 2; ++ai)
#pragma unroll
            for (int mp = 0; mp < 2; ++mp) {
                f32x4 xv[2][2][2];
#pragma unroll
                for (int mm = 0; mm < 2; ++mm) { const size_t ro = (size_t)(row0 + ai * HALF + (mp * 2 + mm) * 16) * DM + col0;
#pragma unroll
                    for (int bj = 0; bj < 2; ++bj)
#pragma unroll
                        for (int n = 0; n < 2; ++n) xv[mm][bj][n] = *(const f32x4*)(src + ro + bj * HALF + n * 16); }
#pragma unroll
                for (int mm = 0; mm < 2; ++mm) { const size_t ro = (size_t)(row0 + ai * HALF + (mp * 2 + mm) * 16) * DM + col0;
#pragma unroll
                    for (int bj = 0; bj < 2; ++bj)
#pragma unroll
                        for (int n = 0; n < 2; ++n) *(f32x4*)(dst + ro + bj * HALF + n * 16) = xv[mm][bj][n] + gv[bj][n] * acc[ai][bj][mp * 2 + mm][n]; }
            }
    }
};
struct EpiBf16 {
    static constexpr bool PERM = true;
    bf16_t* O; int ldc;
    __device__ __forceinline__ void operator()(const f32x4 (&acc)[2][2][4][2], const Unit& u, int wr, int wc, int fr, int fq) const {
        const int row0 = u.pm * BM + wr * 64 + fr, col0 = u.pn * BM + wc * 32 + 8 * fq;
#pragma unroll
        for (int ai = 0; ai < 2; ++ai)
#pragma unroll
            for (int m = 0; m < 4; ++m) { bf16_t* rowp = O + (size_t)(row0 + ai * HALF + m * 16) * ldc + col0;
#pragma unroll
                for (int bj = 0; bj < 2; ++bj) { const f32x4 v0 = acc[ai][bj][m][0], v1 = acc[ai][bj][m][1];
                    u32x4 w; w.x = cvt_pk_bf16(v0[0], v0[1]); w.y = cvt_pk_bf16(v0[2], v0[3]); w.z = cvt_pk_bf16(v1[0], v1[1]); w.w = cvt_pk_bf16(v1[2], v1[3]);
                    *(u32x4*)(rowp + bj * HALF) = w; } }
    }
};

template <class Epi, class Sched>
__device__ __forceinline__ void gemm_phase(LAS unsigned char* lds, const Gemm g, const Sched& S, const Epi& E, const int tid) {
    const int wid = __builtin_amdgcn_readfirstlane(tid >> 6), lane = tid & 63, wr = wid >> 2, wc = wid & 3, fr = lane & 15, fq = lane >> 4;
    const int K = g.lda, nt = g.K / BK;
    unsigned voffA[2], voffB[2];
#pragma unroll
    for (int i = 0; i < 2; ++i) { int R, C; stage_rc(tid * 16 + i * 8192, R, C); const int Rb = Epi::PERM ? ((R & ~31) + perm32(R & 31)) : R;
        voffA[i] = (unsigned)(R * K + C) * 2u; voffB[i] = (unsigned)(Rb * K + C) * 2u; }
    const size_t kstep = (size_t)(BK * 2);
    const size_t hstep = (size_t)HALF * K * 2;
    const size_t tstep = 2 * hstep;
    const unsigned ldsw = (unsigned)wid * 1024u;
    const int aoff = lds_byte(wr * 64 + fr, fq * 8), boff = lds_byte(wc * 32 + fr, fq * 8);
#define PG8_SA(b, h) (((b) * 2 + (h)) * HTB)
#define PG8_SB(b, h) ((4 + (b) * 2 + (h)) * HTB)
#define PG8_STAGE(bufoff, gbase, voff) do { _Pragma("unroll") for (int _i = 0; _i < 2; ++_i) \
        __builtin_amdgcn_global_load_lds((const unsigned*)((const char*)(gbase) + (voff)[_i]), (LAS unsigned*)(lds + (bufoff) + ldsw + _i * 8192), 16, 0, 0); } while (0)
#define PG8_LDA(dst, b, h) do { _Pragma("unroll") for (int m = 0; m < 4; ++m) _Pragma("unroll") for (int k = 0; k < 2; ++k) dst[m][k] = *(const LAS bf16x8*)(lds + PG8_SA(b, h) + aoff + m * 2048 + k * 1024); } while (0)
#define PG8_LDB(dst, b, h) do { _Pragma("unroll") for (int n = 0; n < 2; ++n) _Pragma("unroll") for (int k = 0; k < 2; ++k) dst[n][k] = *(const LAS bf16x8*)(lds + PG8_SB(b, h) + boff + n * 2048 + k * 1024); } while (0)
#define PG8_MMA(ai, bj, At, Bt) do { __builtin_amdgcn_s_setprio(1); _Pragma("unroll") for (int m = 0; m < 4; ++m) _Pragma("unroll") for (int n = 0; n < 2; ++n) _Pragma("unroll") for (int k = 0; k < 2; ++k) \
        acc[ai][bj][m][n] = __builtin_amdgcn_mfma_f32_16x16x32_bf16(Bt[n][k], At[m][k], acc[ai][bj][m][n], 0, 0, 0); __builtin_amdgcn_s_setprio(0); } while (0)
#define PG8_WAIT_V(n) asm volatile("s_waitcnt vmcnt(" #n ")" ::: "memory")
#define PG8_WAIT_L(n) asm volatile("s_waitcnt lgkmcnt(" #n ")" ::: "memory")
#define PG8_BAR __builtin_amdgcn_s_barrier()
#define PG8_SCHED __builtin_amdgcn_sched_barrier(0)
    Unit cur, nxt; int ui = 0;
    if (!S.next(0, cur)) return;
    f32x4 acc[2][2][4][2];
#pragma unroll
    for (int a = 0; a < 2; ++a)
#pragma unroll
        for (int b = 0; b < 2; ++b)
#pragma unroll
            for (int m = 0; m < 4; ++m)
#pragma unroll
                for (int n = 0; n < 2; ++n) acc[a][b][m][n] = (f32x4){0.f, 0.f, 0.f, 0.f};
    bf16x8 At[4][2], B0[2][2], B1[2][2];
    const char* cA = (const char*)g.A + S.aoff(cur, tstep); const char* cB = (const char*)g.Bt + S.boff(cur, tstep);
    PG8_STAGE(PG8_SB(0, 0), cB, voffB); PG8_STAGE(PG8_SA(0, 0), cA, voffA); PG8_STAGE(PG8_SB(0, 1), cB + hstep, voffB); PG8_STAGE(PG8_SA(0, 1), cA + hstep, voffA);
    if (wr == 1) PG8_BAR;
    PG8_WAIT_V(4); PG8_BAR;
    PG8_STAGE(PG8_SB(1, 0), cB + kstep, voffB); PG8_STAGE(PG8_SA(1, 0), cA + kstep, voffA); PG8_STAGE(PG8_SB(1, 1), cB + hstep + kstep, voffB);
    PG8_WAIT_V(6); PG8_BAR;
    for (;;) {
        const bool has_next = S.next(ui + 1, nxt);
        const char* nA = has_next ? (const char*)g.A + S.aoff(nxt, tstep) : cA; const char* nB = has_next ? (const char*)g.Bt + S.boff(nxt, tstep) : cB;
        for (int t = 0; t < nt; t += 2) {
            const bool last = (t == nt - 2);
            const char* a1 = cA + (size_t)(t + 1) * kstep;
            const char* a2 = last ? nA : cA + (size_t)(t + 2) * kstep; const char* b2 = last ? nB : cB + (size_t)(t + 2) * kstep;
            const char* a3 = a2 + kstep; const char* b3 = b2 + kstep;
            PG8_LDB(B0, 0, 0); PG8_SCHED; PG8_LDA(At, 0, 0); PG8_STAGE(PG8_SA(1, 1), a1 + hstep, voffA);
            PG8_WAIT_L(8); PG8_BAR; PG8_WAIT_L(0); PG8_MMA(0, 0, At, B0); PG8_BAR; PG8_SCHED;
            PG8_LDB(B1, 0, 1); PG8_STAGE(PG8_SB(0, 0), b2, voffB);
            PG8_BAR; PG8_WAIT_L(0); PG8_MMA(0, 1, At, B1); PG8_BAR;
            PG8_LDA(At, 0, 1); PG8_STAGE(PG8_SA(0, 0), a2, voffA);
            PG8_BAR; PG8_WAIT_L(0); PG8_MMA(1, 0, At, B0); PG8_BAR; PG8_SCHED;
            PG8_STAGE(PG8_SB(0, 1), b2 + hstep, voffB);
            PG8_WAIT_V(6); PG8_BAR; PG8_MMA(1, 1, At, B1); PG8_BAR;
            PG8_LDB(B0, 1, 0); PG8_SCHED; PG8_LDA(At, 1, 0); PG8_STAGE(PG8_SA(0, 1), a2 + hstep, voffA);
            PG8_WAIT_L(8); PG8_BAR; PG8_WAIT_L(0); PG8_MMA(0, 0, At, B0); PG8_BAR; PG8_SCHED;
            PG8_LDB(B1, 1, 1); PG8_STAGE(PG8_SB(1, 0), b3, voffB);
            PG8_BAR; PG8_WAIT_L(0); PG8_MMA(0, 1, At, B1); PG8_BAR;
            PG8_LDA(At, 1, 1); PG8_STAGE(PG8_SA(1, 0), a3, voffA);
            PG8_BAR; PG8_WAIT_L(0); PG8_MMA(1, 0, At, B0); PG8_BAR; PG8_SCHED;
            PG8_STAGE(PG8_SB(1, 1), b3 + hstep, voffB);
            PG8_WAIT_V(6); PG8_BAR; PG8_MMA(1, 1, At, B1); PG8_BAR;
        }
        E(acc, cur, wr, wc, fr, fq);
        if (!has_next) break;
#pragma unroll
        for (int a = 0; a < 2; ++a)
#pragma unroll
            for (int b = 0; b < 2; ++b)
#pragma unroll
                for (int m = 0; m < 4; ++m)
#pragma unroll
                    for (int n = 0; n < 2; ++n) acc[a][b][m][n] = (f32x4){0.f, 0.f, 0.f, 0.f};
        cur = nxt; cA = nA; cB = nB; ++ui;
    }
    PG8_WAIT_V(0);
    if (wr == 0) PG8_BAR;
    PG8_BAR;
#undef PG8_SA
#undef PG8_SB
#undef PG8_STAGE
#undef PG8_LDA
#undef PG8_LDB
#undef PG8_MMA
#undef PG8_WAIT_V
#undef PG8_WAIT_L
#undef PG8_BAR
#undef PG8_SCHED
}
}

namespace att {
constexpr int D = 128, NW = 8, QBLK = 32, KVBLK = 64;
constexpr float SCALE = 0.088388347648318440f;
constexpr float THR = 8.f;
constexpr int LDQ = 1536, LDK = 1536, LDO = 1024;
constexpr size_t SHM_V = KVBLK * D * 2, SHM_K = KVBLK * D * 2;
#define KSWZ(row, colB) ((row) * 256 + ((colB) ^ (((row) & 7) << 4)))
#define SBAR() __builtin_amdgcn_sched_barrier(0)
__device__ __forceinline__ int crow(int r, int hi) { return (r & 3) + 8 * (r >> 2) + 4 * hi; }
__device__ __forceinline__ unsigned cvtpk(float lo, float hi) { unsigned r; asm volatile("v_cvt_pk_bf16_f32 %0, %1, %2" : "=v"(r) : "v"(lo), "v"(hi)); return r; }
__device__ __forceinline__ bf16x8 ld8(const bf16_t* p) { return *reinterpret_cast<const bf16x8*>(p); }
__device__ __forceinline__ void partialSM(f32x16& p0, f32x16& p1, float& m_reg, float& mn, float& alpha) {
    constexpr float C = SCALE * 1.4426950408889634f;
    float pmax = p0[0];
#pragma unroll
    for (int r = 1; r < 16; ++r) pmax = fmaxf(pmax, p0[r]);
#pragma unroll
    for (int r = 0; r < 16; ++r) pmax = fmaxf(pmax, p1[r]);
    { auto rr = __builtin_amdgcn_permlane32_swap(__float_as_uint(pmax), __float_as_uint(pmax), false, false);
      pmax = fmaxf(__uint_as_float(rr[0]), __uint_as_float(rr[1])); }
    if (__builtin_expect(__all(pmax - m_reg <= THR / SCALE), 1)) { mn = m_reg; alpha = 1.f; }
    else { mn = fmaxf(m_reg, pmax); alpha = __builtin_amdgcn_exp2f((m_reg - mn) * C); m_reg = mn; }
    float mnC = -mn * C;
#pragma unroll
    for (int r = 0; r < 16; ++r) p0[r] = fmaf(p0[r], C, mnC);
#pragma unroll
    for (int r = 0; r < 16; ++r) p1[r] = fmaf(p1[r], C, mnC);
#pragma unroll
    for (int r = 0; r < 16; ++r) p0[r] = __builtin_amdgcn_exp2f(p0[r]);
}
__device__ __forceinline__ void finishSM(f32x16& p0, f32x16& p1, float alpha, float& l_reg, bf16x8& pa0, bf16x8& pa1, bf16x8& pa2, bf16x8& pa3) {
#pragma unroll
    for (int r = 0; r < 16; ++r) p1[r] = __builtin_amdgcn_exp2f(p1[r]);
    float ps = 0;
#pragma unroll
    for (int r = 0; r < 16; ++r) ps += p0[r];
#pragma unroll
    for (int r = 0; r < 16; ++r) ps += p1[r];
    { auto rr = __builtin_amdgcn_permlane32_swap(__float_as_uint(ps), __float_as_uint(ps), false, false);
      ps = __uint_as_float(rr[0]) + __uint_as_float(rr[1]); }
    l_reg = l_reg * alpha + ps;
#define PK4(P, BASE, OUT) do { unsigned a0 = cvtpk(P[BASE + 0], P[BASE + 1]), a1 = cvtpk(P[BASE + 2], P[BASE + 3]);   \
    unsigned b0 = cvtpk(P[BASE + 4], P[BASE + 5]), b1 = cvtpk(P[BASE + 6], P[BASE + 7]);                              \
    auto r0 = __builtin_amdgcn_permlane32_swap(a0, b0, false, false); auto r1 = __builtin_amdgcn_permlane32_swap(a1, b1, false, false); \
    u32x4 w = {r0[0], r1[0], r0[1], r1[1]}; OUT = *reinterpret_cast<bf16x8*>(&w); } while (0)
    PK4(p0, 0, pa0); PK4(p0, 8, pa1); PK4(p1, 0, pa2); PK4(p1, 8, pa3);
#undef PK4
}
__device__ __forceinline__ void pk_p(const f32x16& p0, const f32x16& p1, bf16x8& pa0, bf16x8& pa1, bf16x8& pa2, bf16x8& pa3) {
#define PK4(P, BASE, OUT) do { unsigned a0 = cvtpk(P[BASE + 0], P[BASE + 1]), a1 = cvtpk(P[BASE + 2], P[BASE + 3]);   \
    unsigned b0 = cvtpk(P[BASE + 4], P[BASE + 5]), b1 = cvtpk(P[BASE + 6], P[BASE + 7]);                              \
    auto r0 = __builtin_amdgcn_permlane32_swap(a0, b0, false, false); auto r1 = __builtin_amdgcn_permlane32_swap(a1, b1, false, false); \
    u32x4 w = {r0[0], r1[0], r0[1], r1[1]}; OUT = *reinterpret_cast<bf16x8*>(&w); } while (0)
    PK4(p0, 0, pa0); PK4(p0, 8, pa1); PK4(p1, 0, pa2); PK4(p1, 8, pa3);
#undef PK4
}
__device__ __forceinline__ void qkt(f32x16& p0, f32x16& p1, const bf16_t* Ks, const bf16x8* qr, int r32, int hi) {
    p0 = f32x16{}; p1 = f32x16{};
#pragma unroll
    for (int d0 = 0; d0 < 8; ++d0) { int cb = (d0 * 16 + hi * 8) * 2;
        bf16x8 b0 = *reinterpret_cast<const bf16x8*>((const char*)Ks + KSWZ(r32, cb));
        bf16x8 b1 = *reinterpret_cast<const bf16x8*>((const char*)Ks + KSWZ(32 + r32, cb));
        p0 = __builtin_amdgcn_mfma_f32_32x32x16_bf16(b0, qr[d0], p0, 0, 0, 0);
        p1 = __builtin_amdgcn_mfma_f32_32x32x16_bf16(b1, qr[d0], p1, 0, 0, 0); }
}
__device__ __forceinline__ int v_st(int k, int c) { const int kk = (k & ~0xC) | ((k & 4) << 1) | ((k & 8) >> 1); return ((kk >> 3) * 4 + (c >> 5)) * 512 + ((kk & 7) * 32 + (c & 31)) * 2; }
__device__ __forceinline__ int v_rd_base(int lane) { return ((lane & 3) << 3) | (((lane >> 2) & 3) << 6) | (((lane >> 4) & 1) << 5) | (((lane >> 5) & 1) << 8); }
constexpr int v_rd_off(int d0, int ks, int half) { return d0 * 512 + ks * 4096 + half * 2048; }
template <int OFF> __device__ __forceinline__ s16x4 tr_read(int vb) {
    s16x4 r; asm volatile("ds_read_b64_tr_b16 %0, %1 offset:%2" : "=&v"(r) : "v"(vb), "i"(OFF) : "memory"); return r;
}
template <int D0> __device__ __forceinline__ void pv_one(f32x16& od, int vb, bf16x8 pa0, bf16x8 pa1, bf16x8 pa2, bf16x8 pa3) {
    const s16x4 l0 = tr_read<v_rd_off(D0, 0, 0)>(vb), h0 = tr_read<v_rd_off(D0, 0, 1)>(vb), l1 = tr_read<v_rd_off(D0, 1, 0)>(vb), h1 = tr_read<v_rd_off(D0, 1, 1)>(vb);
    const s16x4 l2 = tr_read<v_rd_off(D0, 2, 0)>(vb), h2 = tr_read<v_rd_off(D0, 2, 1)>(vb), l3 = tr_read<v_rd_off(D0, 3, 0)>(vb), h3 = tr_read<v_rd_off(D0, 3, 1)>(vb);
    asm volatile("s_waitcnt lgkmcnt(0)" ::: "memory"); SBAR();
#define PK(L, H) (bf16x8){L[0], L[1], L[2], L[3], H[0], H[1], H[2], H[3]}
    od = __builtin_amdgcn_mfma_f32_32x32x16_bf16(pa0, PK(l0, h0), od, 0, 0, 0);
    od = __builtin_amdgcn_mfma_f32_32x32x16_bf16(pa1, PK(l1, h1), od, 0, 0, 0);
    od = __builtin_amdgcn_mfma_f32_32x32x16_bf16(pa2, PK(l2, h2), od, 0, 0, 0);
    od = __builtin_amdgcn_mfma_f32_32x32x16_bf16(pa3, PK(l3, h3), od, 0, 0, 0);
#undef PK
}
__device__ __forceinline__ void pv_d0(f32x16* o, int vb, bf16x8 pa0, bf16x8 pa1, bf16x8 pa2, bf16x8 pa3) {
    pv_one<0>(o[0], vb, pa0, pa1, pa2, pa3); pv_one<1>(o[1], vb, pa0, pa1, pa2, pa3); pv_one<2>(o[2], vb, pa0, pa1, pa2, pa3); pv_one<3>(o[3], vb, pa0, pa1, pa2, pa3);
}
__device__ __forceinline__ void attn_dense_body(const bf16_t* __restrict__ Qb, const bf16_t* __restrict__ Kh,
                                                bf16_t* __restrict__ Ob, int seq, char* lds, const int tid) {
    const int wid = tid >> 6, lane = tid & 63, r32 = lane & 31, hi = lane >> 5;
    bf16_t* V_lds = (bf16_t*)lds; bf16_t* K_lds = (bf16_t*)(lds + 2 * SHM_V);
    float* ws = (float*)(lds + 2 * SHM_V + 2 * SHM_K) + wid * 64; float* li_l = ws; float* al_l = ws + 32;
    float m_reg = -1e30f, l_reg = 0; f32x16 o[4] = {}; bf16x8 qr[8];
    const bf16_t* Qw = Qb + (long)(wid * QBLK + r32) * LDQ + hi * 8;
#pragma unroll
    for (int d0 = 0; d0 < 8; ++d0) qr[d0] = ld8(Qw + d0 * 16);
    const int sr = tid >> 4, sc = (tid & 15) * 8, vst0 = v_st(sr, sc), vst1 = v_st(32 + sr, sc);
    const int vb0 = (int)(uintptr_t)V_lds + v_rd_base(lane);
    struct { bf16x8 vs0, vs1, ks0, ks1; } sr_[2];
    const unsigned so0 = (unsigned)(sr * LDK + sc) * 2u, so1 = (unsigned)((32 + sr) * LDK + sc) * 2u;
#define SLOAD(i, k0) do { const char* kb_ = (const char*)Kh + (size_t)(k0) * (LDK * 2); \
    sr_[i].vs0 = *(const bf16x8*)(kb_ + so0 + 512); sr_[i].vs1 = *(const bf16x8*)(kb_ + so1 + 512); \
    sr_[i].ks0 = *(const bf16x8*)(kb_ + so0); sr_[i].ks1 = *(const bf16x8*)(kb_ + so1); } while (0)
#define SWRITE(b, i) do { *(bf16x8*)((char*)V_lds + (b) * SHM_V + vst0) = sr_[i].vs0;          \
    *(bf16x8*)((char*)V_lds + (b) * SHM_V + vst1) = sr_[i].vs1; int kc = sc * 2;               \
    *(bf16x8*)((char*)K_lds + (b) * SHM_K + KSWZ(sr, kc)) = sr_[i].ks0;                       \
    *(bf16x8*)((char*)K_lds + (b) * SHM_K + KSWZ(32 + sr, kc)) = sr_[i].ks1; } while (0)
#define SWAIT() asm volatile("s_waitcnt vmcnt(4)" ::: "memory")
#define RESC(a) do { if (__any((a) < 1.f)) { if (hi == 0) al_l[r32] = (a); asm volatile("s_waitcnt lgkmcnt(0)" ::: "memory"); \
    _Pragma("unroll") for (int d = 0; d < 4; ++d) _Pragma("unroll") for (int r = 0; r < 16; ++r) o[d][r] *= al_l[crow(r, hi)]; } } while (0)
    f32x16 pA0, pA1, pB0, pB1; float mnA, mnB, alA, alB; bf16x8 pa0, pa1, pa2, pa3; const int NT = seq / KVBLK;
    constexpr int SE = 0, SO = 1;
    SLOAD(SE, 0); asm volatile("s_waitcnt vmcnt(0)" ::: "memory"); SWRITE(0, SE); __syncthreads();
    qkt(pA0, pA1, K_lds, qr, r32, hi); partialSM(pA0, pA1, m_reg, mnA, alA);
    SLOAD(SO, KVBLK); if (2 < NT) SLOAD(SE, 2 * KVBLK);
    SWAIT(); SWRITE(1, SO); __syncthreads();
    for (int j = 1; j + 1 < NT; j += 2) {
        SBAR(); qkt(pB0, pB1, (bf16_t*)((char*)K_lds + SHM_K), qr, r32, hi);
        finishSM(pA0, pA1, alA, l_reg, pa0, pa1, pa2, pa3); SBAR();
        SLOAD(SO, (j + 2) * KVBLK); SBAR();
        pv_d0(o, vb0, pa0, pa1, pa2, pa3); partialSM(pB0, pB1, m_reg, mnB, alB);
        __syncthreads(); SWAIT(); SWRITE(0, SE);
        RESC(alB); __syncthreads();
        SBAR(); qkt(pA0, pA1, K_lds, qr, r32, hi);
        finishSM(pB0, pB1, alB, l_reg, pa0, pa1, pa2, pa3); SBAR();
        if (j + 3 < NT) SLOAD(SE, (j + 3) * KVBLK); SBAR();
        pv_d0(o, vb0 + (int)SHM_V, pa0, pa1, pa2, pa3); partialSM(pA0, pA1, m_reg, mnA, alA);
        __syncthreads(); SWAIT(); SWRITE(1, SO);
        RESC(alA); __syncthreads();
    }
    SBAR(); qkt(pB0, pB1, (bf16_t*)((char*)K_lds + SHM_K), qr, r32, hi);
    finishSM(pA0, pA1, alA, l_reg, pa0, pa1, pa2, pa3); SBAR();
    pv_d0(o, vb0, pa0, pa1, pa2, pa3); partialSM(pB0, pB1, m_reg, mnB, alB);
    __syncthreads(); RESC(alB);
    finishSM(pB0, pB1, alB, l_reg, pa0, pa1, pa2, pa3); SBAR();
    pv_d0(o, vb0 + (int)SHM_V, pa0, pa1, pa2, pa3);
    if (hi == 0) li_l[r32] = l_reg; asm volatile("s_waitcnt lgkmcnt(0)" ::: "memory");
    float rli[16];
#pragma unroll
    for (int r = 0; r < 16; ++r) rli[r] = __builtin_amdgcn_rcpf(li_l[crow(r, hi)]);
    bf16_t* Ow = Ob + (long)(wid * QBLK) * LDO;
#pragma unroll
    for (int r = 0; r < 16; ++r) { int orow = crow(r, hi);
#pragma unroll
        for (int d0 = 0; d0 < 4; ++d0) Ow[(long)orow * LDO + d0 * 32 + r32] = (bf16_t)f2bf(o[d0][r] * rli[r]); }
#undef SLOAD
#undef SWRITE
#undef SWAIT
#undef RESC
}
}

#define XB_TMO      128
#define XB_XCNT(j)  (256  + 64 * (j))
#define XB_XSUB(j)  (1280 + 64 * (j))
#define XB_XGEN(j)  (2304 + 64 * (j))
#define XB_TOP      3328
#define XB_TOPGEN   3392
#define XCD_BAR_WORDS 3456
#define XB_SPIN_CAP (1u << 18)

__device__ __forceinline__ unsigned xb_ld(unsigned* p)              { return __hip_atomic_load(p, __ATOMIC_RELAXED, __HIP_MEMORY_SCOPE_AGENT); }
__device__ __forceinline__ unsigned xb_add(unsigned* p, unsigned v) { return __hip_atomic_fetch_add(p, v, __ATOMIC_RELAXED, __HIP_MEMORY_SCOPE_AGENT); }
__device__ __forceinline__ unsigned xb_xcc_id() { return (unsigned)__builtin_amdgcn_s_getreg((3 << 11) | 20) & 0xFu; }
#define XB_SPIN(cond, bar) do { unsigned _sp = 0; while (cond) { __builtin_amdgcn_s_sleep(1); \
    if ((++_sp & 255u) == 0u) { if (xb_ld(&(bar)[XB_TMO])) break; if (_sp > XB_SPIN_CAP) { atomicAdd(&(bar)[XB_TMO], 1u); break; } } } } while (0)

struct XcdBarrier {
    unsigned* bar; unsigned x;
    volatile LAS unsigned* st;
};

__device__ __forceinline__ XcdBarrier xcd_barrier_post(unsigned* bar, volatile LAS unsigned* st) {
    XcdBarrier b; b.bar = bar; b.x = xb_xcc_id(); b.st = st;
    if (threadIdx.x == 0) (void)xb_add(&bar[XB_XCNT(b.x)], 1u);
    return b;
}
__device__ __forceinline__ void xcd_barrier_complete(unsigned* bar, unsigned x, unsigned& nloc, unsigned& nx) {
    const unsigned G = gridDim.x * gridDim.y * gridDim.z;
    unsigned sum, cnt, mine, sp = 0u;
    for (;;) {
        sum = 0u; cnt = 0u; mine = 0u;
#pragma unroll
        for (unsigned j = 0; j < 16; ++j) { const unsigned c = xb_ld(&bar[XB_XCNT(j)]); sum += c; cnt += (c > 0u) ? 1u : 0u; mine = (j == x) ? c : mine; }
        if (sum == G) break;
        __builtin_amdgcn_s_sleep(1);
        if ((++sp & 255u) == 0u) { if (xb_ld(&bar[XB_TMO])) break; if (sp > XB_SPIN_CAP) { atomicAdd(&bar[XB_TMO], 1u); break; } }
    }
    nloc = mine > 0u ? mine : 1u; nx = cnt > 0u ? cnt : 1u;
}

__device__ __forceinline__ void xcd_barrier(const XcdBarrier& b, const bool leader) {
    asm volatile("s_waitcnt vmcnt(0)" ::: "memory");
    __syncthreads();
    if (leader) {
        unsigned* bar = b.bar;
        __builtin_amdgcn_s_waitcnt(0);
        unsigned nloc = b.st[0], nx = b.st[1];
        if (nloc == 0u) { xcd_barrier_complete(bar, b.x, nloc, nx); b.st[0] = nloc; b.st[1] = nx; }
        const unsigned old = xb_add(&bar[XB_XSUB(b.x)], 1u);
        const unsigned gen = old / nloc;
        if (old + 1u == (gen + 1u) * nloc) {
            __builtin_amdgcn_fence(__ATOMIC_RELEASE, "agent");
            asm volatile("s_waitcnt vmcnt(0)" ::: "memory");
            const unsigned og = xb_add(&bar[XB_TOP], 1u);
            const unsigned tg = og / nx;
            if (og + 1u == (tg + 1u) * nx) xb_add(&bar[XB_TOPGEN], 1u);
            else XB_SPIN(xb_ld(&bar[XB_TOPGEN]) == tg, bar);
            __builtin_amdgcn_fence(__ATOMIC_ACQUIRE, "agent");
            xb_add(&bar[XB_XGEN(b.x)], 1u);
            asm volatile("s_waitcnt vmcnt(0)" ::: "memory");
        } else {
            XB_SPIN(xb_ld(&bar[XB_XGEN(b.x)]) == gen, bar);
            __builtin_amdgcn_fence(__ATOMIC_ACQUIRE, "agent");
            asm volatile("s_waitcnt vmcnt(0)" ::: "memory");
        }
    }
    __syncthreads();
}


__device__ __forceinline__ int ml_tok(int dir, int c, int r) {
    if (c == 0) return dir ? (T + 255 - r) : (T + r);
    const int p = (c - 1) * 256 + r; return dir ? (T - 1 - p) : p;
}

__device__ __forceinline__ float block_scan256(float v, float* wtot, int tid, float& total) {
#pragma unroll
    for (int o = 1; o < 64; o <<= 1) { const float t = __shfl_up(v, o); if ((tid & 63) >= o) v += t; }
    if ((tid & 63) == 63 && tid < 256) wtot[tid >> 6] = v;
    __syncthreads();
    const float w0 = wtot[0], w1 = wtot[1], w2 = wtot[2], w3 = wtot[3];
    const int w = tid >> 6;
    v += (w > 0 ? w0 : 0.f) + (w > 1 ? w1 : 0.f) + (w > 2 ? w2 : 0.f);
    total = ((w0 + w1) + w2) + w3;
    return v;
}

__device__ __forceinline__ int srccol(int mode, int n) {
    if (mode == 1) { const int g = n >> 8, r = n & 255; return (r < 128) ? (g * 128 + r) : (FF + g * 128 + (r - 128)); }
    if (mode == 2) return n < 1536 ? n : n + 16;
    return n;
}
__device__ __forceinline__ void transpose_item(const float* W, int K, int Nsrc, int Ndst, int mode, bf16_t* WT, float* scr, int item, int lane) {
    const int nblk = Ndst / 32, kb = item / nblk, nb = item % nblk, k0 = 64 * kb, n0 = 32 * nb;
    const int sc_ = srccol(mode, n0 + (lane & 31));
    float tv[32];
    const float* Wp = W + (size_t)(k0 + (lane >> 5)) * Nsrc + sc_;
#pragma unroll
    for (int i = 0; i < 32; ++i) tv[i] = __builtin_nontemporal_load(Wp + (size_t)(2 * i) * Nsrc);
#pragma unroll
    for (int i = 0; i < 32; ++i) { const int kk = 2 * i + (lane >> 5); scr[kk * 33 + (lane & 31)] = tv[i]; }
    asm volatile("s_waitcnt lgkmcnt(0)" ::: "memory");
    const int c = lane & 7;
#pragma unroll
    for (int j = 0; j < 4; ++j) { const int n = (lane >> 3) + 8 * j; const float* s = scr + (8 * c) * 33 + n;
        u32x4 o; o.x = pk2(s[0 * 33], s[1 * 33]); o.y = pk2(s[2 * 33], s[3 * 33]); o.z = pk2(s[4 * 33], s[5 * 33]); o.w = pk2(s[6 * 33], s[7 * 33]);
        *(u32x4*)(WT + (size_t)(n0 + n) * K + k0 + 8 * c) = o; }
    asm volatile("s_waitcnt lgkmcnt(0)" ::: "memory");
}

__global__ void __launch_bounds__(NTHREADS, 2) fwd_megakernel(Params P) {
    extern __shared__ __attribute__((aligned(16))) unsigned char smem[];
    cg::grid_group grid = cg::this_grid();
    const int wave_s = __builtin_amdgcn_readfirstlane(threadIdx.x >> 6);
    if (threadIdx.x < 4) ((volatile LAS unsigned*)((LAS unsigned char*)smem + LDS_BYTES - 16))[threadIdx.x] = 0u;
    __syncthreads();
    const XcdBarrier xbar = xcd_barrier_post((unsigned*)(P.ws + OFF_BAR), (volatile LAS unsigned*)((LAS unsigned char*)smem + LDS_BYTES - 16));
    for (int ph = 0; ph < P.nprog; ++ph) {
        int wv_ = wave_s; asm volatile("" : "+s"(wv_));
        int tid; asm volatile("v_mbcnt_lo_u32_b32 %0, -1, 0\n\tv_mbcnt_hi_u32_b32 %0, -1, %0" : "=&v"(tid)); tid += wv_ * 64; asm volatile("" : "+v"(tid));
        int bid = blockIdx.x; asm volatile("" : "+s"(bid));
        __attribute__((address_space(1))) unsigned char* wsg_ = (__attribute__((address_space(1))) unsigned char*)P.ws; asm volatile("" : "+s"(wsg_));
        unsigned char* ws = (unsigned char*)wsg_;
        const int wave = wv_;
        const int G = gridDim.x;
#define lane (tid & 63)
#define gw (bid * NWAVES + wave)
#define NGW (G * NWAVES)
#define gtid (bid * NTHREADS + tid)
#define NTALL (G * NTHREADS)
#define W13T ((bf16_t*)(ws + OFF_W13T))
#define W2T ((bf16_t*)(ws + OFF_W2T))
#define CINT ((bf16_t*)(ws + OFF_CINT))
#define COUTT ((bf16_t*)(ws + OFF_COUTT))
#define QKVT ((bf16_t*)(ws + OFF_QKVT))
#define AOT ((bf16_t*)(ws + OFF_AOT))
#define MLINT ((bf16_t*)(ws + OFF_MLINT))
#define MLOT ((bf16_t*)(ws + OFF_MLOT))
#define X ((float*)(ws + OFF_X))
#define H ((bf16_t*)(ws + OFF_H))
#define U ((bf16_t*)(ws + OFF_U))
#define BIG ((bf16_t*)(ws + OFF_BIG))
#define MODV ((float*)(ws + OFF_MODV))
#define GATES ((float*)(ws + OFF_GATES))
#define ST ((float*)(ws + OFF_ST))
#define STN ((float*)(ws + OFF_STN))
#define DEC ((float*)(ws + OFF_DEC))
#define HH ((float*)(ws + OFF_HH))
        const int op = P.prog[ph][0], layer = P.prog[ph][1], a = P.prog[ph][2], M = P.prog[ph][3];
        int gtype = 0; const bf16_t* A = nullptr; const bf16_t* Bt = nullptr; int N = 0, K = 0, ldo = 0, sub = 0; float gs = 1.f; bf16_t* Obf = BIG; float* dst = X; const float* rsrc = X;
        switch (op) {
            case OP_W13:      gtype = 1; A = H;   Bt = W13T + (size_t)(layer * 2 + (a & 1)) * 5632 * 1024; N = 5632; K = 1024; ldo = (a & 8) ? -1 : FF; break;
            case OP_W2:       gtype = 2; A = BIG; Bt = W2T + (size_t)(layer * 2 + (a & 1)) * 1024 * 2816; N = 1024; K = 2816; sub = (a & 1) * 2; gs = 0.5f; if (a & 2) dst = P.out; if (a & 4) dst = HH; if (a & 16) rsrc = P.x; break;
            case OP_CONV_IN:  gtype = 3; A = H;   Bt = CINT + (size_t)a * 3072 * 1024; N = 3072; K = 1024; ldo = 3072; break;
            case OP_CONV_OUT: gtype = 2; A = U;   Bt = COUTT + (size_t)a * 1024 * 1024; N = 1024; K = 1024; sub = 1; break;
            case OP_QKV:      gtype = 3; A = H;   Bt = QKVT; N = 1536; K = 1024; ldo = 1536; break;
            case OP_ATT_OUT:  gtype = 2; A = U;   Bt = AOT; N = 1024; K = 1024; sub = 1; break;
            case OP_ML_IN:    gtype = 3; A = H;   Bt = MLINT; N = 3072; K = 1024; ldo = 3072; break;
            case OP_ML_PROJ:  gtype = 2; A = U;   Bt = MLOT; N = 1024; K = 1024; sub = 1; break;
            default: break;
        }
        if (gtype) {
            const bool split_ctx = (gtype == 2) && (M == MT);
            pg8::Gemm g{A, Bt, split_ctx ? T : M, N, K, K}; pg8::StaticOrder S; S.init(g.M, N, G, bid);
            if (gtype == 1) { pg8::EpiSwiglu E{Obf, ldo}; pg8::gemm_phase<pg8::EpiSwiglu, pg8::StaticOrder>((LAS unsigned char*)smem, g, S, E, tid); }
            else if (gtype == 2) {
                const float* gl = MODV + (size_t)(layer * 2 + 0) * 9216 + sub * 3072 + 2048; const float* gc = MODV + (size_t)(layer * 2 + 1) * 9216 + sub * 3072 + 2048;
                pg8::EpiResid E{rsrc, dst, gl, gc, gs}; pg8::gemm_phase<pg8::EpiResid, pg8::StaticOrder>((LAS unsigned char*)smem, g, S, E, tid);
                if (split_ctx) {
                    pg8::Gemm g2{A + (size_t)T * K, Bt, 256, N, 256, K}; pg8::SplitOrder S2{(K / 256) * 4, G, (bid + 128) % G};
                    pg8::EpiPart E2{(float*)(ws + OFF_PART)}; pg8::gemm_phase<pg8::EpiPart, pg8::SplitOrder>((LAS unsigned char*)smem, g2, S2, E2, tid);
                }
            }
            else { pg8::EpiBf16 E{Obf, ldo}; pg8::gemm_phase<pg8::EpiBf16, pg8::StaticOrder>((LAS unsigned char*)smem, g, S, E, tid); }
        }
        constexpr int I13 = 16 * 176, I2 = 44 * 32, ICI = 16 * 96, ISQ = 16 * 32, IQKV = 16 * 48;
#define PREP_MODV(l, blk0, nblk) do { float* red = (float*)smem; \
            for (int it = (blk0); it < 144; it += (nblk)) { \
                const int n0 = it * 64; \
                const float* Wp = P.mod_w + ((size_t)(l) * 1024 + wave * 128) * 9216 + n0 + lane; \
                float a0 = 0.f, a1 = 0.f; \
                for (int kb = 0; kb < 128; kb += 32) { float wv[32]; \
                    _Pragma("unroll") for (int k = 0; k < 32; ++k) wv[k] = __builtin_nontemporal_load(Wp + (size_t)(kb + k) * 9216); \
                    _Pragma("unroll") for (int k = 0; k < 32; ++k) { a0 += siluf(P.c[wave * 128 + kb + k]) * wv[k]; a1 += siluf(P.cctx[wave * 128 + kb + k]) * wv[k]; } } \
                red[(wave * 2 + 0) * 64 + lane] = a0; red[(wave * 2 + 1) * 64 + lane] = a1; \
                __syncthreads(); \
                if (tid < 128) { const int gq = tid >> 6, ln = tid & 63; float sm_ = 0.f; \
                    _Pragma("unroll") for (int w = 0; w < 8; ++w) sm_ += red[(w * 2 + gq) * 64 + ln]; \
                    MODV[(size_t)((l) * 2 + gq) * 9216 + n0 + ln] = sm_ + P.mod_b[(l) * 9216 + n0 + ln]; } \
                __syncthreads(); } } while (0)
#define PREP_NITEMS(l) (2 * I13 + 2 * I2 + (((l) % 3) == 1 ? IQKV : ICI) + ISQ)
#define PREP_TRANS(l, lo, hi, w0, nw) do { float* scr = (float*)(smem + wave * 8448); \
            for (int it = (lo) + (w0); it < (hi); it += (nw)) { int r = it; \
                if (r < 2 * I13) { const int mi = (l) * 2 + r / I13; transpose_item(P.w13 + (size_t)mi * 1024 * 5632, 1024, 5632, 5632, 1, W13T + (size_t)mi * 5632 * 1024, scr, r % I13, lane); continue; } r -= 2 * I13; \
                if (r < 2 * I2) { const int mi = (l) * 2 + r / I2; transpose_item(P.w2 + (size_t)mi * 2816 * 1024, 2816, 1024, 1024, 0, W2T + (size_t)mi * 1024 * 2816, scr, r % I2, lane); continue; } r -= 2 * I2; \
                const int kd = (l) % 3, jj = (l) / 3; \
                if (kd == 0) { if (r < ICI) { transpose_item(P.conv_in + (size_t)jj * 1024 * 3072, 1024, 3072, 3072, 0, CINT + (size_t)jj * 3072 * 1024, scr, r, lane); continue; } r -= ICI; \
                    transpose_item(P.conv_out + (size_t)jj * 1024 * 1024, 1024, 1024, 1024, 0, COUTT + (size_t)jj * 1024 * 1024, scr, r, lane); } \
                else if (kd == 1) { if (r < IQKV) { transpose_item(P.qkv, 1024, 1536, 1536, 0, QKVT, scr, r, lane); continue; } r -= IQKV; \
                    transpose_item(P.attn_o, 1024, 1024, 1024, 0, AOT, scr, r, lane); } \
                else { if (r < ICI) { transpose_item(P.ml_in, 1024, 3088, 3072, 2, MLINT, scr, r, lane); continue; } r -= ICI; \
                    transpose_item(P.ml_o, 1024, 1024, 1024, 0, MLOT, scr, r, lane); } } } while (0)
        if (op == OP_W13 && layer < 3) {
            const int nwg = (M / 256) * 22, nfull = nwg % G;
            if (nfull == 0 || bid >= nfull) {
                const int ib = nfull ? bid - nfull : bid, nidle = nfull ? G - nfull : G, l1 = layer + 1, tot = PREP_NITEMS(l1), cut = tot / 3;
                if ((a & 1) == 0) { PREP_MODV(l1, ib, nidle); PREP_TRANS(l1, 0, cut, ib * NWAVES + wave, nidle * NWAVES); }
                else { PREP_TRANS(l1, cut, tot, ib * NWAVES + wave, nidle * NWAVES); }
            }
        }
        if (op == OP_PREP) {
            PREP_MODV(0, bid, G);
            PREP_TRANS(0, 0, PREP_NITEMS(0), gw, NGW);
        } else if (op == OP_MOD) {
            const int subl = a & 15, nks = (a >> 4) & 255, psub = (a >> 12) & 15, player = (a >> 16) & 255; const float pgs = ((a >> 24) & 1) ? 0.5f : 1.f;
#define MOD_XIN(m_) ((a & (1 << 28)) ? ((m_) < T ? P.x + (size_t)(m_) * 1024 : P.ctx + (size_t)((m_) - T) * 1024) : (((a & (1 << 29)) && (m_) >= T) ? P.ctx + (size_t)((m_) - T) * 1024 : X + (size_t)(m_) * 1024))
            const float* gp = P.norm_g + (layer * 3 + subl) * 1024;
            f32x4 gsl[4], shl[4];
            { const float* mvl = MODV + (size_t)(layer * 2) * 9216 + subl * 3072;
#pragma unroll
              for (int j = 0; j < 4; ++j) { const int col = 4 * lane + 256 * j; gsl[j] = *(const f32x4*)(gp + col) * (*(const f32x4*)(mvl + 1024 + col) + 1.f); shl[j] = *(const f32x4*)(mvl + col); } }
            f32x4 vn[4];
            { const int m0_ = gw < M ? gw : 0;
#pragma unroll
              for (int j = 0; j < 4; ++j) vn[j] = ((const f32x4*)MOD_XIN(m0_) + lane)[64 * j]; }
            for (int m = gw; m < M; m += NGW) {
                f32x4* xr = (f32x4*)(X + (size_t)m * 1024) + lane;
                f32x4 v[4]; float ss = 0.f;
#pragma unroll
                for (int j = 0; j < 4; ++j) v[j] = vn[j];
                const int mnx = (m + NGW < M) ? m + NGW : m;
#pragma unroll
                for (int j = 0; j < 4; ++j) vn[j] = ((const f32x4*)MOD_XIN(mnx) + lane)[64 * j];
                f32x4 gs[4], sh[4];
#pragma unroll
                for (int j = 0; j < 4; ++j) { gs[j] = gsl[j]; sh[j] = shl[j]; }
                if (m >= T) {
                    const float* mvc = MODV + (size_t)(layer * 2 + 1) * 9216 + subl * 3072;
#pragma unroll
                    for (int j = 0; j < 4; ++j) { const int col = 4 * lane + 256 * j; gs[j] = *(const f32x4*)(gp + col) * (*(const f32x4*)(mvc + 1024 + col) + 1.f); sh[j] = *(const f32x4*)(mvc + col); }
                    if (nks) {
                        const float* pg = MODV + (size_t)(player * 2 + 1) * 9216 + psub * 3072 + 2048;
                        const f32x4* pp = (const f32x4*)((const float*)(ws + OFF_PART) + (size_t)(m - T) * 1024) + lane;
#pragma unroll
                        for (int j = 0; j < 4; ++j) { f32x4 sacc = pp[64 * j];
                            for (int ks = 1; ks < nks; ++ks) sacc += pp[(size_t)ks * 65536 + 64 * j];
                            v[j] += (*(const f32x4*)(pg + 4 * lane + 256 * j) * pgs) * sacc; xr[64 * j] = v[j]; }
                    }
                }
#pragma unroll
                for (int j = 0; j < 4; ++j) ss += (v[j].x * v[j].x + v[j].y * v[j].y) + (v[j].z * v[j].z + v[j].w * v[j].w);
                const float rstd = rsqrtf(wave_sum(ss) * (1.f / 1024.f) + EPS);
                bf16_t* orow = H + (size_t)m * 1024;
#pragma unroll
                for (int j = 0; j < 4; ++j) { const int col = 4 * lane + 256 * j;
                    const f32x4 o = (v[j] * rstd) * gs[j] + sh[j];
                    u32x2 w; w.x = pk2(o.x, o.y); w.y = pk2(o.z, o.w); *(u32x2*)(orow + col) = w; }
            }
#undef MOD_XIN
        } else if (op == OP_CONV_GATE) {
            const float* ck = P.conv_k + (size_t)a * 3 * 1024;
            for (int idx = gtid; idx < M * 128; idx += NTALL) {
                const int m = idx >> 7, c8 = (idx & 127) * 8;
                const bf16_t* row = BIG + (size_t)m * 3072;
                const bool hasp = (m != 0) && (m != T), hasn = (m != T - 1) && (m != MT - 1);
                const u32x4 z = {0u, 0u, 0u, 0u};
                const u32x4 bg = *(const u32x4*)(row + c8);
                const u32x4 cg1 = *(const u32x4*)(row + 1024 + c8), xv1 = *(const u32x4*)(row + 2048 + c8);
                const u32x4 cg0 = hasp ? *(const u32x4*)(row - 3072 + 1024 + c8) : z, xv0 = hasp ? *(const u32x4*)(row - 3072 + 2048 + c8) : z;
                const u32x4 cg2 = hasn ? *(const u32x4*)(row + 3072 + 1024 + c8) : z, xv2 = hasn ? *(const u32x4*)(row + 3072 + 2048 + c8) : z;
                float o[8];
#pragma unroll
                for (int q = 0; q < 4; ++q) {
                    const float k0a = ck[c8 + 2 * q], k0b = ck[c8 + 2 * q + 1], k1a = ck[1024 + c8 + 2 * q], k1b = ck[1024 + c8 + 2 * q + 1], k2a = ck[2048 + c8 + 2 * q], k2b = ck[2048 + c8 + 2 * q + 1];
                    o[2 * q]     = blo(bg[q]) * (k0a * (blo(cg0[q]) * blo(xv0[q])) + k1a * (blo(cg1[q]) * blo(xv1[q])) + k2a * (blo(cg2[q]) * blo(xv2[q])));
                    o[2 * q + 1] = bhi(bg[q]) * (k0b * (bhi(cg0[q]) * bhi(xv0[q])) + k1b * (bhi(cg1[q]) * bhi(xv1[q])) + k2b * (bhi(cg2[q]) * bhi(xv2[q])));
                }
                u32x4 w; w.x = pk2(o[0], o[1]); w.y = pk2(o[2], o[3]); w.z = pk2(o[4], o[5]); w.w = pk2(o[6], o[7]);
                *(u32x4*)(U + (size_t)m * 1024 + c8) = w;
            }
        } else if (op == OP_ROPE) {
            const int s = lane >> 5, i = lane & 31;
            const float inv = exp2f(-(float)i * (13.287712379549449f / 32.f));
            for (int m = gw; m < MT; m += NGW) {
                bf16_t* row = BIG + (size_t)m * 1536;
                float cs = 1.f, sn = 0.f;
                if (m < T) { const float pos = s ? (float)(m & 63) : (float)(m >> 6); const float ang = pos * inv; float rev = ang * 0.15915494309189535f; rev -= floorf(rev);
                    cs = __builtin_amdgcn_cosf(rev); sn = __builtin_amdgcn_sinf(rev); }
                float x1[10], x2[10];
#pragma unroll
                for (int hs = 0; hs < 10; ++hs) { const bf16_t* hp = row + hs * 128 + s * 64 + i; x1[hs] = bf2f(hp[0]); x2[hs] = bf2f(hp[32]); }
                const float gq1 = P.q_g[s * 64 + i], gq2 = P.q_g[s * 64 + 32 + i], gk1 = P.k_g[s * 64 + i], gk2 = P.k_g[s * 64 + 32 + i];
#pragma unroll
                for (int hs = 0; hs < 10; ++hs) {
                    bf16_t* hp = row + hs * 128 + s * 64 + i;
                    const float rstd = rsqrtf(wave_sum(x1[hs] * x1[hs] + x2[hs] * x2[hs]) * (1.f / 128.f) + EPS);
                    const float y1 = x1[hs] * rstd * (hs < 8 ? gq1 : gk1), y2 = x2[hs] * rstd * (hs < 8 ? gq2 : gk2);
                    hp[0] = (bf16_t)f2bf(y1 * cs - y2 * sn); hp[32] = (bf16_t)f2bf(y2 * cs + y1 * sn);
                }
            }
        } else if (op == OP_ATT) {
            for (int it = bid; it < 520; it += G) {
                const bf16_t *Qp, *Kp, *Vp; bf16_t* Op; int seq;
                if (it < 512) { const int h = it >> 6, qb = it & 63; Qp = BIG + (size_t)(qb * 256) * 1536 + h * 128; Kp = BIG + 1024 + (h >> 2) * 128; Vp = BIG + 1280 + (h >> 2) * 128;
                    Op = U + (size_t)(qb * 256) * 1024 + h * 128; seq = MT; }
                else { const int h = it - 512; Qp = BIG + (size_t)T * 1536 + h * 128; Kp = BIG + (size_t)T * 1536 + 1024 + (h >> 2) * 128; Vp = BIG + (size_t)T * 1536 + 1280 + (h >> 2) * 128;
                    Op = U + (size_t)T * 1024 + h * 128; seq = TC; }
                att::attn_dense_body(Qp, Kp, Op, seq, (char*)smem, tid);
                __syncthreads();
            }
        } else if (op == OP_ML_IN) {
            float* sW = (float*)smem;
            { float tw[32];
#pragma unroll
              for (int q = 0; q < 32; ++q) { const int i = tid + q * NTHREADS; tw[q] = P.ml_in[(size_t)(i >> 4) * 3088 + 1536 + (i & 15)]; }
#pragma unroll
              for (int q = 0; q < 32; ++q) sW[tid + q * NTHREADS] = tw[q]; }
            __syncthreads();
            const int gq = tid & 15, tl = tid >> 4;
            const int nbusy = (MT / 256) * 12 - 3 * G;
            const int g0 = (nbusy > 0 && nbusy < G) ? nbusy : 0;
            if (bid >= g0) for (int grp = bid - g0; grp < MT / 32; grp += G - g0) {
                const int m = grp * 32 + tl; const u32x4* hp = (const u32x4*)(H + (size_t)m * 1024); float acc = 0.f;
#pragma unroll 16
                for (int kk = 0; kk < 128; ++kk) { const u32x4 hv = hp[kk]; const float* wp = sW + (kk * 8) * 16 + gq;
                    acc += blo(hv.x) * wp[0] + bhi(hv.x) * wp[16] + blo(hv.y) * wp[32] + bhi(hv.y) * wp[48] + blo(hv.z) * wp[64] + bhi(hv.z) * wp[80] + blo(hv.w) * wp[96] + bhi(hv.w) * wp[112]; }
                GATES[(size_t)m * 16 + gq] = acc + P.ml_b[gq];
            }
            __syncthreads();
        } else if (op == OP_ML_STATE) {
            char* sVt = (char*)smem; char* sKt = (char*)smem + 32768; float* sa = (float*)(smem + 131072); float* sw = sa + 256;
            const int r32 = lane & 31, hi = lane >> 5;
            for (int it = bid; it < 64 * 8; it += G) {
                const int c = it >> 3, hd = it & 7, dir = hd >> 2, head = hd & 3;
                const int sr = tid >> 4, sc = (tid & 15) * 8;
                u32x4 pv0[2], pv1[2], pkk[2];
#define ML_LOADT(kt_) do { _Pragma("unroll") for (int h2 = 0; h2 < 2; ++h2) { const int m_ = ml_tok(dir, c, (kt_) * 64 + h2 * 32 + sr); const bf16_t* rowp = BIG + (size_t)m_ * 3072; \
                    pv0[h2] = *(const u32x4*)(rowp + 512 + head * 256 + sc); pv1[h2] = *(const u32x4*)(rowp + 512 + head * 256 + 128 + sc); pkk[h2] = *(const u32x4*)(rowp + head * 128 + sc); } } while (0)
                ML_LOADT(0);
                __syncthreads();
                float av = 0.f, igv = 0.f;
                if (tid < 256) { const int m = ml_tok(dir, c, tid); const float* gp = GATES + (size_t)m * 16; av = logsigf(gp[(2 * dir + 1) * 4 + head]); igv = gp[(2 * dir) * 4 + head]; }
                int tsc_ = tid; asm volatile("" : "+v"(tsc_)); float Aend; const float Ar = block_scan256(av, sa, tsc_, Aend);
                if (tid < 256) sw[tid] = __expf(Aend - Ar + igv) * 0.08838834764831845f;
                f32x16 acc[4] = {}; float nacc = 0.f;
                const int vbase = (int)(uintptr_t)sVt + (wave >> 2) * 16384 + (wave & 3) * 512 + att::v_rd_base(lane);
                const int kbase = (int)(uintptr_t)sKt + att::v_rd_base(lane);
                for (int kt = 0; kt < 4; ++kt) {
                    __syncthreads();
#pragma unroll
                    for (int h2 = 0; h2 < 2; ++h2) {
                        const int row = h2 * 32 + sr, s = kt * 64 + row;
                        const u32x4 v0 = pv0[h2], v1 = pv1[h2], kk = pkk[h2];
                        const float wsc = sw[s];
                        u32x4 ks; ks.x = pk2(blo(kk.x) * wsc, bhi(kk.x) * wsc); ks.y = pk2(blo(kk.y) * wsc, bhi(kk.y) * wsc); ks.z = pk2(blo(kk.z) * wsc, bhi(kk.z) * wsc); ks.w = pk2(blo(kk.w) * wsc, bhi(kk.w) * wsc);
                        const int off = att::v_st(row, sc);
                        *(u32x4*)(sVt + off) = v0; *(u32x4*)(sVt + 16384 + off) = v1; *(u32x4*)(sKt + off) = ks;
                    }
                    __syncthreads();
                    ML_LOADT(kt < 3 ? kt + 1 : 3);
                    if (tid < 128) { for (int s = 0; s < 64; ++s) nacc += bf2f(*(const bf16_t*)(sKt + att::v_st(s, tid & ~7) + (tid & 7) * 2)); }
#define ML_FR(base, D0, KS) ({ const s16x4 l_ = att::tr_read<att::v_rd_off(D0, KS, 0)>(base), h_ = att::tr_read<att::v_rd_off(D0, KS, 1)>(base); (bf16x8){l_[0], l_[1], l_[2], l_[3], h_[0], h_[1], h_[2], h_[3]}; })
#define ML_KS(KS) do { bf16x8 a_ = ML_FR(vbase, 0, KS), b0_ = ML_FR(kbase, 0, KS), b1_ = ML_FR(kbase, 1, KS), b2_ = ML_FR(kbase, 2, KS), b3_ = ML_FR(kbase, 3, KS); \
                        asm volatile("s_waitcnt lgkmcnt(0)" ::: "memory"); __builtin_amdgcn_sched_barrier(0); \
                        acc[0] = __builtin_amdgcn_mfma_f32_32x32x16_bf16(a_, b0_, acc[0], 0, 0, 0); acc[1] = __builtin_amdgcn_mfma_f32_32x32x16_bf16(a_, b1_, acc[1], 0, 0, 0); \
                        acc[2] = __builtin_amdgcn_mfma_f32_32x32x16_bf16(a_, b2_, acc[2], 0, 0, 0); acc[3] = __builtin_amdgcn_mfma_f32_32x32x16_bf16(a_, b3_, acc[3], 0, 0, 0); } while (0)
                    ML_KS(0); ML_KS(1); ML_KS(2); ML_KS(3);
#undef ML_KS
#undef ML_FR
                }
#undef ML_LOADT
                float* UT = ST + (size_t)(c * 8 + hd) * 32768;
#pragma unroll
                for (int db = 0; db < 4; ++db)
#pragma unroll
                    for (int r = 0; r < 16; ++r) UT[(32 * wave + att::crow(r, hi)) * 128 + 32 * db + r32] = acc[db][r];
                if (tid < 128) STN[(c * 8 + hd) * 128 + tid] = nacc;
                if (tid == 0) DEC[c * 8 + hd] = __expf(Aend);
            }
            __syncthreads();
        } else if (op == OP_ML_SCAN) {
            bf16_t* CTb = (bf16_t*)(ws + OFF_CTB);
            for (int e = gtid; e < 8 * 32768 + 8 * 128; e += NTALL) {
                const bool mat = e < 8 * 32768;
                const int hd = mat ? (e >> 15) : ((e - 8 * 32768) >> 7), idx = mat ? (e & 32767) : ((e - 8 * 32768) & 127);
                float* p = mat ? (ST + (size_t)hd * 32768 + idx) : (STN + hd * 128 + idx);
                const size_t cs = mat ? (size_t)8 * 32768 : (size_t)8 * 128;
                bf16_t* cb = CTb + (size_t)hd * 32768 + idx;
                const float* dp = DEC + hd;
                float run = 0.f;
                for (int half = 0; half < 2; ++half) {
                    float uv[32], dc[32];
                    { const float* pl = p;
#pragma unroll
                      for (int c = 0; c < 32; ++c) { uv[c] = *pl; pl += cs; dc[c] = dp[c * 8]; } }
#pragma unroll
                    for (int c = 0; c < 32; ++c) { *p = run; if (mat) *cb = (bf16_t)f2bf(run); run = dc[c] * run + uv[c]; p += cs; cb += (size_t)8 * 32768; }
                    dp += 32 * 8;
                }
                *p = run; if (mat) *cb = (bf16_t)f2bf(run);
            }
        } else if (op == OP_ML_OUT) {
            const bf16_t* CTb = (const bf16_t*)(ws + OFF_CTB);
            char* sK = (char*)smem; char* sV = (char*)smem + 65536;
            float* sA0 = (float*)(smem + 131072); float* sB0 = sA0 + 256; float* sA1 = sB0 + 256; float* sB1 = sA1 + 256; float* sN0 = sB1 + 256; float* sN1 = sN0 + 128;
            float* sInv0 = sN1 + 128; float* sInv1 = sInv0 + 256; float* wtot = sInv1 + 256;
            for (int it = bid; it < 256; it += G) {
                const int j = it >> 2, head = it & 3;
                __syncthreads();
                {
                    float av0 = 0.f, ig0 = 0.f, av1 = 0.f, ig1 = 0.f;
                    int tsc_ = tid; asm volatile("" : "+v"(tsc_));
                    if (tsc_ < 256) { const float* g0 = GATES + (size_t)(256 * j + tsc_) * 16; const float* g1 = GATES + (size_t)(256 * j + 255 - tsc_) * 16;
                        av0 = logsigf(g0[4 + head]); ig0 = g0[head]; av1 = logsigf(g1[12 + head]); ig1 = g1[8 + head]; }
                    else if (tsc_ < 384) sN0[tsc_ - 256] = STN[((j + 1) * 8 + head) * 128 + (tsc_ - 256)];
                    else sN1[tsc_ - 384] = STN[((64 - j) * 8 + 4 + head) * 128 + (tsc_ - 384)];
                    float tot0, tot1; const float Ar0 = block_scan256(av0, wtot, tsc_, tot0); const float Ar1 = block_scan256(av1, wtot + 4, tsc_, tot1);
                    if (tsc_ < 256) { sA0[tsc_] = Ar0; sB0[tsc_] = ig0 - Ar0; sA1[255 - tsc_] = Ar1; sB1[255 - tsc_] = ig1 - Ar1; }
                }
                { int tk_ = tid; asm volatile("" : "+v"(tk_)); const int sr = tk_ >> 4, sc = (tk_ & 15) * 8;
#pragma unroll
                  for (int kt = 0; kt < 4; ++kt)
#pragma unroll
                      for (int h2 = 0; h2 < 2; ++h2) { const int row = h2 * 32 + sr; const int m = 256 * j + kt * 64 + row;
                          *(u32x4*)(sK + kt * 16384 + KSWZ(row, sc * 2)) = *(const u32x4*)(BIG + (size_t)m * 3072 + head * 128 + sc); } }
                __syncthreads();
                int tq_ = tid; asm volatile("" : "+v"(tq_));
                const int r32 = tq_ & 31, hi = (tq_ >> 5) & 1;
                const int rq = 32 * wave + r32; const int mq = 256 * j + rq;
                bf16x8 qr[8];
                const float At0 = sA0[rq], At1 = sA1[rq], ea0 = __expf(At0), ea1 = __expf(At1);
                float qn0 = 0.f, qn1 = 0.f;
#pragma unroll
                for (int d0 = 0; d0 < 8; ++d0) {
                    const u32x4 qq = *(const u32x4*)(BIG + (size_t)mq * 3072 + 1536 + head * 128 + hi * 8 + d0 * 16);
                    qr[d0] = *(const bf16x8*)&qq;
                    const float* n0 = sN0 + d0 * 16 + hi * 8; const float* n1 = sN1 + d0 * 16 + hi * 8;
                    qn0 += blo(qq.x) * n0[0] + bhi(qq.x) * n0[1] + blo(qq.y) * n0[2] + bhi(qq.y) * n0[3] + blo(qq.z) * n0[4] + bhi(qq.z) * n0[5] + blo(qq.w) * n0[6] + bhi(qq.w) * n0[7];
                    qn1 += blo(qq.x) * n1[0] + bhi(qq.x) * n1[1] + blo(qq.y) * n1[2] + bhi(qq.y) * n1[3] + blo(qq.z) * n1[4] + bhi(qq.z) * n1[5] + blo(qq.w) * n1[6] + bhi(qq.w) * n1[7];
                }
                { auto rr = __builtin_amdgcn_permlane32_swap(__float_as_uint(qn0), __float_as_uint(qn0), false, false); qn0 = (__uint_as_float(rr[0]) + __uint_as_float(rr[1])) * ea0; }
                { auto rr = __builtin_amdgcn_permlane32_swap(__float_as_uint(qn1), __float_as_uint(qn1), false, false); qn1 = (__uint_as_float(rr[0]) + __uint_as_float(rr[1])) * ea1; }
                for (int vh = 0; vh < 2; ++vh) {
                    __syncthreads();
                    { int tv_ = tid; asm volatile("" : "+v"(tv_)); const int sr = tv_ >> 4, sc = (tv_ & 15) * 8;
#pragma unroll
                      for (int kt = 0; kt < 4; ++kt)
#pragma unroll
                          for (int h2 = 0; h2 < 2; ++h2) { const int row = h2 * 32 + sr; const int m = 256 * j + kt * 64 + row;
                              *(u32x4*)(sV + kt * 16384 + att::v_st(row, sc)) = *(const u32x4*)(BIG + (size_t)m * 3072 + 512 + head * 256 + vh * 128 + sc); } }
                    __syncthreads();
                    for (int dir = 0; dir < 2; ++dir) {
                        const int c = dir ? (64 - j) : (j + 1), hd = dir * 4 + head;
                        const float At = dir ? At1 : At0, ea = dir ? ea1 : ea0; const float* sB = dir ? sB1 : sB0; float* sInv = dir ? sInv1 : sInv0;
                        f32x16 o[4] = {};
                        {
                            const bf16_t* CT = CTb + (size_t)(c * 8 + hd) * 32768 + (size_t)(vh * 128 + r32) * 128 + hi * 8;
#pragma unroll
                            for (int d0 = 0; d0 < 8; ++d0) {
                                const u32x4 qq = *(const u32x4*)&qr[d0];
                                u32x4 qv; qv.x = cvt_pk_bf16(blo(qq.x) * ea, bhi(qq.x) * ea); qv.y = cvt_pk_bf16(blo(qq.y) * ea, bhi(qq.y) * ea); qv.z = cvt_pk_bf16(blo(qq.z) * ea, bhi(qq.z) * ea); qv.w = cvt_pk_bf16(blo(qq.w) * ea, bhi(qq.w) * ea);
                                const bf16x8 qsd = *(const bf16x8*)&qv;
                                const bf16x8 b0 = att::ld8(CT + 0 * 4096 + d0 * 16), b1 = att::ld8(CT + 1 * 4096 + d0 * 16), b2 = att::ld8(CT + 2 * 4096 + d0 * 16), b3 = att::ld8(CT + 3 * 4096 + d0 * 16);
                                o[0] = __builtin_amdgcn_mfma_f32_32x32x16_bf16(qsd, b0, o[0], 0, 0, 0); o[1] = __builtin_amdgcn_mfma_f32_32x32x16_bf16(qsd, b1, o[1], 0, 0, 0);
                                o[2] = __builtin_amdgcn_mfma_f32_32x32x16_bf16(qsd, b2, o[2], 0, 0, 0); o[3] = __builtin_amdgcn_mfma_f32_32x32x16_bf16(qsd, b3, o[3], 0, 0, 0);
                                if ((d0 & 3) == 3) __builtin_amdgcn_sched_barrier(0);
                            }
                        }
                        float nsum = 0.f;
                        int tl_ = tid; asm volatile("" : "+v"(tl_)); const int vb0 = (int)(uintptr_t)sV + att::v_rd_base(tl_ & 63);
                        const int kt0 = dir ? (wave >> 1) : 0, kt1 = dir ? 4 : ((wave >> 1) + 1);
                        for (int kt = kt0; kt < kt1; ++kt) {
                            f32x16 p0, p1;
                            att::qkt(p0, p1, (const bf16_t*)(sK + kt * 16384), qr, r32, hi);
#pragma unroll
                            for (int r = 0; r < 16; ++r) { const int s0 = kt * 64 + att::crow(r, hi), s1 = s0 + 32;
                                const bool k0 = dir ? (s0 >= rq) : (s0 <= rq), k1 = dir ? (s1 >= rq) : (s1 <= rq);
                                p0[r] = k0 ? p0[r] * __expf(At + sB[s0]) * 0.08838834764831845f : 0.f;
                                p1[r] = k1 ? p1[r] * __expf(At + sB[s1]) * 0.08838834764831845f : 0.f;
                                nsum += p0[r] + p1[r]; }
                            bf16x8 pa0, pa1, pa2, pa3;
                            att::pk_p(p0, p1, pa0, pa1, pa2, pa3);
                            att::pv_d0(o, vb0 + kt * 16384, pa0, pa1, pa2, pa3);
                        }
                        if (vh == 0) {
                            auto rr = __builtin_amdgcn_permlane32_swap(__float_as_uint(nsum), __float_as_uint(nsum), false, false);
                            const float Nt = __uint_as_float(rr[0]) + __uint_as_float(rr[1]) + (dir ? qn1 : qn0); const float invn = 1.f / fmaxf(fabsf(Nt), 1.f);
                            if (hi == 0) sInv[wave * 32 + r32] = invn;
                            asm volatile("s_waitcnt lgkmcnt(0)" ::: "memory");
                        }
                        int ts_ = tid; asm volatile("" : "+v"(ts_)); const int r32s = ts_ & 31, his = (ts_ >> 5) & 1;
                        if (dir == 0) {
#pragma unroll
                            for (int r = 0; r < 16; ++r) { const int m = 256 * j + 32 * wave + att::crow(r, his); const float ri = sInv[wave * 32 + att::crow(r, his)];
                                float* hp = HH + (size_t)m * 1024 + head * 256 + vh * 128 + r32s;
#pragma unroll
                                for (int d0 = 0; d0 < 4; ++d0) hp[d0 * 32] = o[d0][r] * ri; }
                        } else {
#pragma unroll
                            for (int rh = 0; rh < 4; ++rh) {
                                float prev[4][4];
#pragma unroll
                                for (int r8 = 0; r8 < 4; ++r8) { const int r = rh * 4 + r8; const int m = 256 * j + 32 * wave + att::crow(r, his);
                                    const float* hp = HH + (size_t)m * 1024 + head * 256 + vh * 128 + r32s;
#pragma unroll
                                    for (int d0 = 0; d0 < 4; ++d0) prev[r8][d0] = hp[d0 * 32]; }
#pragma unroll
                                for (int r8 = 0; r8 < 4; ++r8) { const int r = rh * 4 + r8; const int m = 256 * j + 32 * wave + att::crow(r, his); const float ri = sInv[wave * 32 + att::crow(r, his)];
                                    float* hp = HH + (size_t)m * 1024 + head * 256 + vh * 128 + r32s;
#pragma unroll
                                    for (int d0 = 0; d0 < 4; ++d0) hp[d0 * 32] = prev[r8][d0] + o[d0][r] * ri; }
                            }
                        }
                    }
                }
                __syncthreads();
                for (int ib = 0; ib < 8; ++ib) {
                    int tf_ = tid; asm volatile("" : "+v"(tf_));
                    const int tt = (tf_ >> 4) + 32 * ib, vq = tf_ & 15; const int m = 256 * j + tt;
                    const float* hp = HH + (size_t)m * 1024 + head * 256 + vq * 16;
                    float hh[16]; float ss = 0.f;
#pragma unroll
                    for (int q = 0; q < 4; ++q) { const f32x4 h0 = *(const f32x4*)(hp + 4 * q); hh[4 * q] = h0.x; hh[4 * q + 1] = h0.y; hh[4 * q + 2] = h0.z; hh[4 * q + 3] = h0.w; }
#pragma unroll
                    for (int q = 0; q < 16; ++q) ss += hh[q] * hh[q];
                    ss += __shfl_xor(ss, 1); ss += __shfl_xor(ss, 2); ss += __shfl_xor(ss, 4); ss += __shfl_xor(ss, 8);
                    const float rstd = rsqrtf(ss * (1.f / 256.f) + EPS);
                    const float* gn = P.ml_g + head * 256 + vq * 16;
                    const u32x4* op_ = (const u32x4*)(BIG + (size_t)m * 3072 + 2048 + head * 256 + vq * 16); const u32x4 o0 = op_[0], o1 = op_[1];
                    const float ov[16] = {blo(o0.x), bhi(o0.x), blo(o0.y), bhi(o0.y), blo(o0.z), bhi(o0.z), blo(o0.w), bhi(o0.w), blo(o1.x), bhi(o1.x), blo(o1.y), bhi(o1.y), blo(o1.z), bhi(o1.z), blo(o1.w), bhi(o1.w)};
                    float y[16];
#pragma unroll
                    for (int q = 0; q < 16; ++q) y[q] = sigmf(ov[q]) * (hh[q] * rstd * gn[q]);
                    u32x4 w0, w1; w0.x = pk2(y[0], y[1]); w0.y = pk2(y[2], y[3]); w0.z = pk2(y[4], y[5]); w0.w = pk2(y[6], y[7]);
                    w1.x = pk2(y[8], y[9]); w1.y = pk2(y[10], y[11]); w1.z = pk2(y[12], y[13]); w1.w = pk2(y[14], y[15]);
                    u32x4* up = (u32x4*)(U + (size_t)m * 1024 + head * 256 + vq * 16); up[0] = w0; up[1] = w1;
                }
            }
        }
        if (ph + 1 < P.nprog) { if (P.nprog < 0) grid.sync();   xcd_barrier(xbar, tid == 0); if (PROBE & 8) xcd_barrier(xbar, tid == 0); }
    }
}

extern "C" void kernel_launch(void* const* d_in, const int* in_sizes, int n_in, void* d_out, int out_size, void* d_ws, size_t ws_size, hipStream_t stream) {
    static int grid_blocks = 0;
    if (grid_blocks == 0) {
        if (n_in != 20 || ws_size < WS_END || out_size != T * DM) { fprintf(stderr, "kernel_launch: unexpected shapes: n_in %d ws %zu (need %zu) out %d\n", n_in, ws_size, (size_t)WS_END, out_size); grid_blocks = -1; return; }
        int dev = 0, cus = 0, per_cu = 0;
        hipGetDevice(&dev);
        hipDeviceGetAttribute(&cus, hipDeviceAttributeMultiprocessorCount, dev);
        if (hipFuncSetAttribute((const void*)fwd_megakernel, hipFuncAttributeMaxDynamicSharedMemorySize, LDS_BYTES) != hipSuccess) { fprintf(stderr, "kernel_launch: hipFuncSetAttribute failed\n"); grid_blocks = -1; return; }
        if (hipOccupancyMaxActiveBlocksPerMultiprocessor(&per_cu, (const void*)fwd_megakernel, NTHREADS, LDS_BYTES) != hipSuccess || per_cu < 1) { fprintf(stderr, "kernel_launch: occupancy query gave %d\n", per_cu); per_cu = 1; }
        (void)hipGetLastError();
        grid_blocks = cus * per_cu;
    }
    if (grid_blocks < 0) return;
    Params p{};
    const float** pp[20] = {&p.x, &p.c, &p.ctx, &p.cctx, &p.mod_w, &p.mod_b, &p.norm_g, &p.w13, &p.w2, &p.conv_in, &p.conv_k, &p.conv_out, &p.qkv, &p.q_g, &p.k_g, &p.attn_o, &p.ml_in, &p.ml_b, &p.ml_g, &p.ml_o};
    for (int i = 0; i < 20; ++i) *pp[i] = (const float*)d_in[i];
    p.out = (float*)d_out; p.ws = (unsigned char*)d_ws;
    int n = 0;
    auto add = [&](int op, int layer, int a, int M) { p.prog[n][0] = op; p.prog[n][1] = layer; p.prog[n][2] = a; p.prog[n][3] = M; ++n; };
    add(OP_PREP, 0, 0, 0); if (PROBE & 16) add(OP_PREP, 0, 0, 0);
    int pend = 0;
    auto addmod = [&](int layer, int sub, int M) { add(OP_MOD, layer, sub | (M == MT ? pend : 0) | ((layer == 0 && sub == 0) ? (1 << 28) : 0) | ((layer == 0 && sub == 1) ? (1 << 29) : 0), M); pend = 0; };
    auto addres = [&](int op, int layer, int a, int M, int K, int sub, int half) { if ((PROBE & 64) && op == OP_W2) add(op, layer, (a & 1) | 4, T); add(op, layer, a, M); if (M == MT) pend = ((K / 256) << 4) | (sub << 12) | (layer << 16) | (half << 24); };
    int cnt[3] = {0, 0, 0};
    for (int layer = 0; layer < 4; ++layer) {
        const int kind = layer % 3, j = cnt[kind]++;
        const bool ctx_in = layer <= 2, ctx_out = layer <= 1;
        const int Min = ctx_in ? MT : T, Mout = ctx_out ? MT : T;
        addmod(layer, 0, Min); add(OP_W13, layer, 0, Min); if (PROBE & 32) add(OP_W13, layer, 0, Min); if (PROBE & 128) add(OP_W13, layer, 8, Min); addres(OP_W2, layer, (layer == 0 ? 16 : 0), Min, 2816, 0, 1);
        addmod(layer, 1, Min);
        if (kind == 0) { add(OP_CONV_IN, layer, j, Mout); if (PROBE & 256) add(OP_CONV_IN, layer, j, Mout); add(OP_CONV_GATE, layer, j, Mout); addres(OP_CONV_OUT, layer, j, Mout, 1024, 1, 0); }
        else if (kind == 1) { add(OP_QKV, layer, 0, MT); if (PROBE & 256) add(OP_QKV, layer, 0, MT); add(OP_ROPE, layer, 0, MT); if (PROBE & 512) { add(OP_QKV, layer, 0, MT); add(OP_ROPE, layer, 0, MT); } add(OP_ATT, layer, 0, MT); if (PROBE & 2) add(OP_ATT, layer, 0, MT); addres(OP_ATT_OUT, layer, 0, Mout, 1024, 1, 0); }
        else { add(OP_ML_IN, layer, 0, MT); if (PROBE & 256) add(OP_ML_IN, layer, 0, MT); add(OP_ML_STATE, layer, 0, 0); if (PROBE & 1) add(OP_ML_STATE, layer, 0, 0); add(OP_ML_SCAN, layer, 0, 0); add(OP_ML_OUT, layer, 0, 0); if (PROBE & 1) add(OP_ML_OUT, layer, 0, 0); add(OP_ML_PROJ, layer, 0, T); }
        addmod(layer, 2, Mout); add(OP_W13, layer, 1, Mout); if (PROBE & 32) add(OP_W13, layer, 1, Mout); if (PROBE & 128) add(OP_W13, layer, 9, Mout); addres(OP_W2, layer, 1 | (layer == 3 ? 2 : 0), Mout, 2816, 2, 1);
    }
    p.nprog = n;
    if (hipMemsetAsync((char*)d_ws + OFF_BAR, 0, 16384, stream) != hipSuccess) { fprintf(stderr, "kernel_launch: memset failed\n"); return; }
    void* args[] = {&p};
    hipError_t e = hipLaunchCooperativeKernel((const void*)fwd_megakernel, dim3(grid_blocks), dim3(NTHREADS), args, LDS_BYTES, stream);
    if (e != hipSuccess) fprintf(stderr, "cooperative launch failed: %s (grid %d)\n", hipGetErrorString(e), grid_blocks);
}
```
